# Optimizing an MI355X kernel written in HIP

```python
import math
import jax, jax.numpy as jnp
from jax import lax
import numpy as np

D_MODEL = 2048
BATCH = 1
SEQ = 8192
DEPTH = 2

D_MIX = D_MODEL
ATT_WIDTH = D_MIX // 2
HYENA_WIDTH = D_MIX - ATT_WIDTH
HEAD_DIM = 128
N_Q_HEADS = ATT_WIDTH // HEAD_DIM
N_KV_HEADS = 2
GQA_GROUP = N_Q_HEADS // N_KV_HEADS
KV_WIDTH = N_KV_HEADS * HEAD_DIM
HYENA_ORDER = 2
D_IN = ATT_WIDTH + 2 * KV_WIDTH + (HYENA_ORDER + 1) * HYENA_WIDTH
FILTER_EMB = 33
FILTER_HIDDEN = 64
DECAY_TARGET = 1e-2
FAST_DECAY_PCT = 0.3
SLOW_DECAY_PCT = 1.5
D_FF = 5504
GRID_W = 64
Q_BLOCK = 128
ROPE_THETA = 10000.0
ROW_DIMS = HEAD_DIM // 2
COL_DIMS = HEAD_DIM - ROW_DIMS
ALPHA = (2.0 * DEPTH) ** 0.25
BETA = (8.0 * DEPTH) ** -0.25
LN_EPS = 1e-5
RMS_EPS = 1e-6

kernel_name = "hybrid_attn_hyena_deepnorm_encoder"


def layer_norm(x, g, b):
    xf = x.astype(jnp.float32)
    mu = jnp.mean(xf, axis=-1, keepdims=True)
    var = jnp.mean(jnp.square(xf - mu), axis=-1, keepdims=True)
    return ((xf - mu) * lax.rsqrt(var + LN_EPS) * g + b).astype(x.dtype)


def rms_norm(x, g):
    xf = x.astype(jnp.float32)
    ms = jnp.mean(jnp.square(xf), axis=-1, keepdims=True)
    return (xf * lax.rsqrt(ms + RMS_EPS) * g).astype(x.dtype)


def dwconv3(x, w, b):
    xp = jnp.pad(x, ((0, 0), (1, 1), (0, 0)))
    return xp[:, :-2] * w[0] + xp[:, 1:-1] * w[1] + xp[:, 2:] * w[2] + b


def rope_tables(L):
    rows = L // GRID_W
    row_pos = jnp.repeat(jnp.arange(rows, dtype=jnp.float32), GRID_W)
    col_pos = jnp.tile(jnp.arange(GRID_W, dtype=jnp.float32), rows)

    def axis_table(pos, dims):
        inv = ROPE_THETA ** (-jnp.arange(0, dims, 2, dtype=jnp.float32) / dims)
        ang = pos[:, None] * inv[None, :]
        ang = jnp.concatenate([ang, ang], axis=-1)
        return jnp.cos(ang), jnp.sin(ang)

    cos_r, sin_r = axis_table(row_pos, ROW_DIMS)
    cos_c, sin_c = axis_table(col_pos, COL_DIMS)
    return cos_r, sin_r, cos_c, sin_c


def rotate_half(x):
    x1, x2 = jnp.split(x, 2, axis=-1)
    return jnp.concatenate([-x2, x1], axis=-1)


def apply_axial_rope(x, tables):
    cos_r, sin_r, cos_c, sin_c = tables
    xr, xc = x[..., :ROW_DIMS], x[..., ROW_DIMS:]
    xr = xr * cos_r[None, :, None, :] + rotate_half(xr) * sin_r[None, :, None, :]
    xc = xc * cos_c[None, :, None, :] + rotate_half(xc) * sin_c[None, :, None, :]
    return jnp.concatenate([xr, xc], axis=-1).astype(x.dtype)


def attention_group(q, k, v, q_g, k_g, tables):
    B, L, _ = q.shape
    q = apply_axial_rope(rms_norm(q.reshape(B, L, N_Q_HEADS, HEAD_DIM), q_g), tables)
    k = apply_axial_rope(rms_norm(k.reshape(B, L, N_KV_HEADS, HEAD_DIM), k_g), tables)
    v = v.reshape(B, L, N_KV_HEADS, HEAD_DIM)
    q = q.reshape(B, L, N_KV_HEADS, GQA_GROUP, HEAD_DIM).transpose(0, 2, 3, 1, 4)
    k = k.transpose(0, 2, 1, 3)
    v = v.transpose(0, 2, 1, 3)
    nb = L // Q_BLOCK
    qb = jnp.moveaxis(q.reshape(B, N_KV_HEADS, GQA_GROUP, nb, Q_BLOCK, HEAD_DIM), 3, 0)
    scale = HEAD_DIM ** -0.5

    def block(qi):
        s = jnp.einsum('bhgqd,bhkd->bhgqk', qi, k).astype(jnp.float32) * scale
        p = jax.nn.softmax(s, axis=-1)
        return jnp.einsum('bhgqk,bhkd->bhgqd', p.astype(v.dtype), v)

    o = lax.map(block, qb)
    return o.transpose(1, 0, 4, 2, 3, 5).reshape(B, L, ATT_WIDTH)


def hyena_filters(L, w1, b1, f1, w2, b2, f2, w3, b3, decay):
    bands = (FILTER_EMB - 1) // 2
    t = jnp.linspace(0.0, 1.0, L, dtype=jnp.float32)[:, None]
    w = 2.0 * math.pi * jnp.arange(L, dtype=jnp.float32)[:, None] / L
    f = jnp.linspace(1e-4, bands - 1, bands, dtype=jnp.float32)[None, :]
    z = jnp.concatenate([t, jnp.cos(f * w), -jnp.sin(f * w)], axis=-1)
    h = jnp.sin(f1 * (z @ w1 + b1))
    h = jnp.sin(f2 * (h @ w2 + b2))
    h = (h @ w3 + b3).astype(jnp.float32).reshape(L, 2, HYENA_WIDTH)
    h = h * jnp.exp(-t[:, :, None] * jnp.abs(decay).astype(jnp.float32)[None])
    h = h / jnp.sum(jnp.abs(h), axis=(0, 1), keepdims=True)
    return h[:, 0], h[:, 1]


def bidir_fftconv(z, h_fwd, h_bwd, skip):
    L = z.shape[1]
    C = z.shape[2]
    kern = jnp.concatenate([h_fwd, jnp.zeros((1, C), jnp.float32), h_bwd[1:][::-1]], axis=0)
    K = jnp.fft.rfft(kern, n=2 * L, axis=0)
    Z = jnp.fft.rfft(z.astype(jnp.float32), n=2 * L, axis=1)
    y = jnp.fft.irfft(Z * K[None], n=2 * L, axis=1)[:, :L]
    return (y + z.astype(jnp.float32) * skip).astype(z.dtype)


def hyena_group(u, conv_w, conv_b, w1, b1, f1, w2, b2, f2, w3, b3, decay, skip):
    u = dwconv3(u, conv_w, conv_b)
    x0, x1, v = jnp.split(u, 3, axis=-1)
    h_fwd, h_bwd = hyena_filters(u.shape[1], w1, b1, f1, w2, b2, f2, w3, b3, decay)
    return x0 * bidir_fftconv(x1 * v, h_fwd, h_bwd, skip)


def setup_inputs(seed: int = 0) -> dict:
    key = jax.random.key(seed)
    ks = iter(jax.random.split(key, 48))

    def nrm(shape, scale):
        return jax.random.normal(next(ks), shape, jnp.float32) * scale

    def gain(shape):
        return 1.0 + nrm(shape, 0.1)

    s_in = D_MODEL ** -0.5
    x = nrm((BATCH, SEQ, D_MODEL), 1.0)
    ln_in_g = gain((D_MODEL,))
    ln_in_b = nrm((D_MODEL,), 0.02)
    w_q = nrm((DEPTH, D_MODEL, ATT_WIDTH), s_in)
    w_k = nrm((DEPTH, D_MODEL, KV_WIDTH), s_in)
    w_v = nrm((DEPTH, D_MODEL, KV_WIDTH), s_in * BETA)
    w_gates = nrm((DEPTH, D_MODEL, 2 * HYENA_WIDTH), s_in)
    w_hv = nrm((DEPTH, D_MODEL, HYENA_WIDTH), s_in * BETA)
    w_in = jnp.concatenate([w_q, w_k, w_v, w_gates, w_hv], axis=-1)
    q_norm_g = gain((DEPTH, HEAD_DIM))
    k_norm_g = gain((DEPTH, HEAD_DIM))
    hy_conv_w = nrm((DEPTH, 3, 3 * HYENA_WIDTH), 3 ** -0.5)
    hy_conv_b = nrm((DEPTH, 3 * HYENA_WIDTH), 0.02)
    filt_w1 = nrm((DEPTH, FILTER_EMB, FILTER_HIDDEN), FILTER_EMB ** -0.5)
    filt_b1 = nrm((DEPTH, FILTER_HIDDEN), 0.02)
    filt_f1 = gain((DEPTH, FILTER_HIDDEN))
    filt_w2 = nrm((DEPTH, FILTER_HIDDEN, FILTER_HIDDEN), FILTER_HIDDEN ** -0.5)
    filt_b2 = nrm((DEPTH, FILTER_HIDDEN), 0.02)
    filt_f2 = gain((DEPTH, FILTER_HIDDEN))
    filt_w3 = nrm((DEPTH, FILTER_HIDDEN, 2 * HYENA_WIDTH), FILTER_HIDDEN ** -0.5)
    filt_b3 = nrm((DEPTH, 2 * HYENA_WIDTH), 0.02)
    min_decay = abs(math.log(DECAY_TARGET)) / SLOW_DECAY_PCT
    max_decay = abs(math.log(DECAY_TARGET)) / FAST_DECAY_PCT
    base_decay = jnp.linspace(min_decay, max_decay, HYENA_WIDTH, dtype=jnp.float32)
    filt_decay = base_decay[None, None, :] * (1.0 + nrm((DEPTH, 2, HYENA_WIDTH), 0.05))
    hy_skip = nrm((DEPTH, HYENA_WIDTH), 0.1)
    att_out_g = gain((DEPTH, ATT_WIDTH))
    hy_out_g = gain((DEPTH, HYENA_WIDTH))
    w_out = nrm((DEPTH, D_MIX, D_MODEL), D_MIX ** -0.5 * BETA)
    b_out = nrm((DEPTH, D_MODEL), 0.02)
    ln1_g = gain((DEPTH, D_MODEL))
    ln1_b = nrm((DEPTH, D_MODEL), 0.02)
    w_up = nrm((DEPTH, D_MODEL, 2 * D_FF), s_in)
    b_up = nrm((DEPTH, 2 * D_FF), 0.02)
    ffn_conv_w = nrm((DEPTH, 3, D_FF), 3 ** -0.5)
    ffn_conv_b = nrm((DEPTH, D_FF), 0.02)
    w_down = nrm((DEPTH, D_FF, D_MODEL), D_FF ** -0.5 * BETA)
    b_down = nrm((DEPTH, D_MODEL), 0.02)
    ln2_g = gain((DEPTH, D_MODEL))
    ln2_b = nrm((DEPTH, D_MODEL), 0.02)
    return {
        "x": x, "ln_in_g": ln_in_g, "ln_in_b": ln_in_b, "w_in": w_in,
        "q_norm_g": q_norm_g, "k_norm_g": k_norm_g,
        "hy_conv_w": hy_conv_w, "hy_conv_b": hy_conv_b,
        "filt_w1": filt_w1, "filt_b1": filt_b1, "filt_f1": filt_f1,
        "filt_w2": filt_w2, "filt_b2": filt_b2, "filt_f2": filt_f2,
        "filt_w3": filt_w3, "filt_b3": filt_b3, "filt_decay": filt_decay, "hy_skip": hy_skip,
        "att_out_g": att_out_g, "hy_out_g": hy_out_g, "w_out": w_out, "b_out": b_out,
        "ln1_g": ln1_g, "ln1_b": ln1_b, "w_up": w_up, "b_up": b_up,
        "ffn_conv_w": ffn_conv_w, "ffn_conv_b": ffn_conv_b, "w_down": w_down, "b_down": b_down,
        "ln2_g": ln2_g, "ln2_b": ln2_b,
    }


def reference(x, ln_in_g, ln_in_b, w_in, q_norm_g, k_norm_g, hy_conv_w, hy_conv_b,
              filt_w1, filt_b1, filt_f1, filt_w2, filt_b2, filt_f2, filt_w3, filt_b3,
              filt_decay, hy_skip, att_out_g, hy_out_g, w_out, b_out, ln1_g, ln1_b,
              w_up, b_up, ffn_conv_w, ffn_conv_b, w_down, b_down, ln2_g, ln2_b):
    L = x.shape[1]
    tables = rope_tables(L)
    x = layer_norm(x, ln_in_g, ln_in_b)
    c_q = ATT_WIDTH
    c_k = c_q + KV_WIDTH
    c_v = c_k + KV_WIDTH
    for l in range(DEPTH):
        proj = x @ w_in[l]
        q, k, v, hy = proj[..., :c_q], proj[..., c_q:c_k], proj[..., c_k:c_v], proj[..., c_v:]
        a = rms_norm(attention_group(q, k, v, q_norm_g[l], k_norm_g[l], tables), att_out_g[l])
        h = rms_norm(hyena_group(hy, hy_conv_w[l], hy_conv_b[l], filt_w1[l], filt_b1[l], filt_f1[l],
                                 filt_w2[l], filt_b2[l], filt_f2[l], filt_w3[l], filt_b3[l],
                                 filt_decay[l], hy_skip[l]), hy_out_g[l])
        mix = jnp.concatenate([a, h], axis=-1) @ w_out[l] + b_out[l]
        x = layer_norm(ALPHA * x + mix, ln1_g[l], ln1_b[l])
        up = x @ w_up[l] + b_up[l]
        gate, val = jnp.split(up, 2, axis=-1)
        gate = dwconv3(gate, ffn_conv_w[l], ffn_conv_b[l])
        ffn = (jax.nn.gelu(gate) * val) @ w_down[l] + b_down[l]
        x = layer_norm(ALPHA * x + ffn, ln2_g[l], ln2_b[l])
    return x
```

```cpp
#define MK_N_LAUNCHES 1
#include <hip/hip_runtime.h>
#include <hip/hip_bf16.h>
#include <cstdio>
#include <cstdint>
#include <cmath>
namespace pg8 {
#define PG8_LAS __attribute__((address_space(3)))
typedef unsigned short bf16_t;
typedef short bf16x8 __attribute__((ext_vector_type(8)));
typedef float f32x4 __attribute__((ext_vector_type(4)));
typedef unsigned u32x4 __attribute__((ext_vector_type(4)));
constexpr int BM = 256, BK = 64, HALF = 128, HTB = HALF * BK * 2  , STAGE_BYTES = 8 * HTB, NXCD = 8, WGM = 8;

__host__ __device__ __forceinline__ int lds_byte(int r, int c) { const int st = (r >> 4) * 2 + (c >> 5), rr = r & 15, cc = c & 31, ob = rr * 64 + cc * 2; return st * 1024 + (ob ^ (((ob >> 9) & 1) << 5)); }
__host__ __device__ __forceinline__ void stage_rc(int b, int& R, int& C) { const int st = b / 1024, sb = b % 1024, swz = sb ^ (((sb >> 9) & 1) << 5); R = (st >> 1) * 16 + swz / 64; C = (st & 1) * 32 + (swz % 64) / 2; }
__host__ __device__ __forceinline__ int perm32(int rho) { const int n = rho >> 4, i = rho & 15; return 8 * (i >> 2) + 4 * n + (i & 3); }

struct Unit { int pm, pn; };
struct Gemm { const bf16_t* A; const bf16_t* Bt; int M, N, K; };

struct StaticOrder {
    int nM, nN, nwg, G, c;
    __host__ __device__ void init(int M, int N, int G_, int c_) { nM = M / BM; nN = N / BM; nwg = nM * nN; G = G_; c = c_; }
    __host__ __device__ bool next(int i, Unit& u) const {
        const long L = (long)i * G + c; if (L >= nwg) return false;
        int wgid = (int)L; { const int q = nwg / NXCD, r = nwg % NXCD, xcd = wgid % NXCD, off = wgid / NXCD; wgid = (xcd < r ? xcd * (q + 1) : r * (q + 1) + (xcd - r) * q) + off; }
        const int nig = WGM * nN, gid = wgid / nig, fm = gid * WGM, gsz = (nM - fm) < WGM ? (nM - fm) : WGM;
        u.pm = fm + ((wgid % nig) % gsz); u.pn = (wgid % nig) / gsz; return true;
    }
    __device__ __forceinline__ void a_ready(const Unit&) const {}
    __device__ __forceinline__ void done(const Unit&) const {}
};

__device__ __forceinline__ unsigned cvt_pk_bf16(float lo, float hi) { unsigned r; asm volatile("v_cvt_pk_bf16_f32 %0, %1, %2" : "=v"(r) : "v"(lo), "v"(hi)); return r; }
typedef float f32x2 __attribute__((ext_vector_type(2)));
__device__ __forceinline__ f32x2 gelu_pk(f32x2 v) {
    const f32x2 av = __builtin_elementwise_abs(v), d = av * 0.2316418882f + 1.0f;
    f32x2 t; t.x = __builtin_amdgcn_rcpf(d.x); t.y = __builtin_amdgcn_rcpf(d.y);
    f32x2 q = t * 0.5307027145f + (-0.7265760135f); q = q * t + 0.7107068705f; q = q * t + (-0.142248368f); q = q * t + 0.127414796f; q = q * t;
    const f32x2 s = (v * v) * (-0.72134752044f);
    f32x2 e; e.x = __builtin_amdgcn_exp2f(s.x); e.y = __builtin_amdgcn_exp2f(s.y);
    const f32x2 m = v * (q * e), r = v - m;
    f32x2 o; o.x = v.x < 0.f ? m.x : r.x; o.y = v.y < 0.f ? m.y : r.y; return o;
}

template <int ACT  > struct EpiBf16 {
    static constexpr bool PERM = true, AFTER_DRAIN = false; static_assert(ACT == 0 || ACT == 1, "EpiBf16: ACT is 0 (none) or 1 (gelu_pk)");
    bf16_t* O; int ldc; const float* bias; int split_cols; size_t split_stride; float scale0;
    __device__ __forceinline__ void operator()(const f32x4 (&acc)[2][2][4][2], const Unit& u, int wr, int wc, int fr, int fq) const {
        const int row0 = u.pm * BM + wr * 64 + fr; int colt = u.pn * BM; bf16_t* base = O;
        float sc = 1.f; if (split_cols) { const int t = colt / split_cols; base += (size_t)t * split_stride; colt -= t * split_cols; if (t == 0) sc = scale0; }
        const int col0 = colt + wc * 32 + 8 * fq, bcol0 = u.pn * BM + wc * 32 + 8 * fq;
        f32x4 bv[2][2];
#pragma unroll
        for (int bj = 0; bj < 2; ++bj)
#pragma unroll
            for (int n = 0; n < 2; ++n) bv[bj][n] = bias ? *(const f32x4*)(bias + bcol0 + bj * HALF + 4 * n) : (f32x4){0.f, 0.f, 0.f, 0.f};
#pragma unroll
        for (int ai = 0; ai < 2; ++ai)
#pragma unroll
            for (int m = 0; m < 4; ++m) { bf16_t* rowp = base + (size_t)(row0 + ai * HALF + m * 16) * ldc + col0;
#pragma unroll
                for (int bj = 0; bj < 2; ++bj) { f32x4 v0 = acc[ai][bj][m][0] + bv[bj][0], v1 = acc[ai][bj][m][1] + bv[bj][1];
                    if (ACT == 1) { f32x2 a = gelu_pk((f32x2){v0[0], v0[1]}), b = gelu_pk((f32x2){v0[2], v0[3]}), c = gelu_pk((f32x2){v1[0], v1[1]}), d = gelu_pk((f32x2){v1[2], v1[3]});
                        v0 = (f32x4){a.x, a.y, b.x, b.y}; v1 = (f32x4){c.x, c.y, d.x, d.y}; }
                    v0 = v0 * sc; v1 = v1 * sc; u32x4 w; w.x = cvt_pk_bf16(v0[0], v0[1]); w.y = cvt_pk_bf16(v0[2], v0[3]); w.z = cvt_pk_bf16(v1[0], v1[1]); w.w = cvt_pk_bf16(v1[2], v1[3]);
                    *(u32x4*)(rowp + bj * HALF) = w; } }
    }
};
struct EpiResid {
    static constexpr bool PERM = false, AFTER_DRAIN = false;
    float* X; int ldc; const float* bias; float alpha;
    __device__ __forceinline__ void operator()(const f32x4 (&acc)[2][2][4][2], const Unit& u, int wr, int wc, int fr, int fq) const {
        const int row0 = u.pm * BM + wr * 64 + fr, col0 = u.pn * BM + wc * 32 + 4 * fq;
        f32x4 bv[2][2];
#pragma unroll
        for (int bj = 0; bj < 2; ++bj)
#pragma unroll
            for (int n = 0; n < 2; ++n) bv[bj][n] = *(const f32x4*)(bias + col0 + bj * HALF + n * 16);
#pragma unroll
        for (int ai = 0; ai < 2; ++ai)
#pragma unroll
            for (int m = 0; m < 4; ++m) { float* rowp = X + (size_t)(row0 + ai * HALF + m * 16) * ldc + col0;
#pragma unroll
                for (int bj = 0; bj < 2; ++bj)
#pragma unroll
                    for (int n = 0; n < 2; ++n) { const f32x4 xv = *(const f32x4*)(rowp + bj * HALF + n * 16); *(f32x4*)(rowp + bj * HALF + n * 16) = xv * alpha + acc[ai][bj][m][n] + bv[bj][n]; }
                asm volatile("" ::: "memory"); }
    }
};
template <class Epi, class Sched, bool ALIGN_EPI = false, bool SP2 = false>
__device__ __forceinline__ void gemm_phase(PG8_LAS unsigned char* lds, const Gemm g, const Sched& S, const Epi& E, const int tid) {
    const int wid = __builtin_amdgcn_readfirstlane(tid >> 6), lane = tid & 63, wr = wid >> 2, wc = wid & 3, fr = lane & 15, fq = lane >> 4;
    const int K = g.K, nt = K / BK;
    unsigned voffA[2], voffB[2];
#pragma unroll
    for (int i = 0; i < 2; ++i) { int R, C; stage_rc(tid * 16 + i * 8192, R, C); const int Rb = Epi::PERM ? ((R & ~31) + perm32(R & 31)) : R;
        voffA[i] = (unsigned)(R * K + C) * 2u; voffB[i] = (unsigned)(Rb * K + C) * 2u; }
    const size_t kstep = (size_t)(BK * 2);
    const size_t hstep = (size_t)HALF * K * 2;
    const size_t tstep = 2 * hstep;
    const unsigned ldsw = (unsigned)wid * 1024u;
    const int aoff = lds_byte(wr * 64 + fr, fq * 8), boff = lds_byte(wc * 32 + fr, fq * 8);
#define PG8_SA(b, h) (((b) * 2 + (h)) * HTB)
#define PG8_SB(b, h) ((4 + (b) * 2 + (h)) * HTB)
#define PG8_STAGE(bufoff, gbase, voff) do { _Pragma("unroll") for (int _i = 0; _i < 2; ++_i) \
        __builtin_amdgcn_global_load_lds((const unsigned*)((const char*)(gbase) + (voff)[_i]), (PG8_LAS unsigned*)(lds + (bufoff) + ldsw + _i * 8192), 16, 0, 0); } while (0)
#define PG8_LDA(dst, b, h) do { _Pragma("unroll") for (int m = 0; m < 4; ++m) _Pragma("unroll") for (int k = 0; k < 2; ++k) dst[m][k] = *(const PG8_LAS bf16x8*)(lds + PG8_SA(b, h) + aoff + m * 2048 + k * 1024); } while (0)
#define PG8_LDB(dst, b, h) do { _Pragma("unroll") for (int n = 0; n < 2; ++n) _Pragma("unroll") for (int k = 0; k < 2; ++k) dst[n][k] = *(const PG8_LAS bf16x8*)(lds + PG8_SB(b, h) + boff + n * 2048 + k * 1024); } while (0)
#define PG8_MMA(ai, bj, At, Bt) do { __builtin_amdgcn_s_setprio(1); _Pragma("unroll") for (int m = 0; m < 4; ++m) _Pragma("unroll") for (int n = 0; n < 2; ++n) _Pragma("unroll") for (int k = 0; k < 2; ++k) \
        acc[ai][bj][m][n] = __builtin_amdgcn_mfma_f32_16x16x32_bf16(Bt[n][k], At[m][k], acc[ai][bj][m][n], 0, 0, 0); __builtin_amdgcn_s_setprio(0); } while (0)
#define PG8_WAIT_V(n) asm volatile("s_waitcnt vmcnt(" #n ")" ::: "memory")
#define PG8_WAIT_L(n) asm volatile("s_waitcnt lgkmcnt(" #n ")" ::: "memory")
#define PG8_BAR __builtin_amdgcn_s_barrier()
#define PG8_SCHED __builtin_amdgcn_sched_barrier(0)
    Unit cur, nxt; int ui = 0;
    if (!S.next(0, cur)) return;
    f32x4 acc[2][2][4][2];
#pragma unroll
    for (int a = 0; a < 2; ++a)
#pragma unroll
        for (int b = 0; b < 2; ++b)
#pragma unroll
            for (int m = 0; m < 4; ++m)
#pragma unroll
                for (int n = 0; n < 2; ++n) acc[a][b][m][n] = (f32x4){0.f, 0.f, 0.f, 0.f};
    bf16x8 At[4][2], B0[2][2], B1[2][2];
    const char* cA = (const char*)g.A + (size_t)cur.pm * tstep; const char* cB = (const char*)g.Bt + (size_t)cur.pn * tstep;
    S.a_ready(cur);
    if constexpr (SP2) {
        PG8_STAGE(PG8_SB(0, 0), cB, voffB); PG8_STAGE(PG8_SB(0, 1), cB + hstep, voffB); PG8_STAGE(PG8_SA(0, 0), cA, voffA); PG8_STAGE(PG8_SA(0, 1), cA + hstep, voffA);
        if (wr == 1) PG8_BAR;
        PG8_WAIT_V(2); PG8_BAR;
        PG8_STAGE(PG8_SB(1, 0), cB + kstep, voffB); PG8_STAGE(PG8_SA(1, 0), cA + kstep, voffA); PG8_STAGE(PG8_SB(1, 1), cB + hstep + kstep, voffB);
        PG8_WAIT_V(6); PG8_BAR;
    } else {
        PG8_STAGE(PG8_SB(0, 0), cB, voffB); PG8_STAGE(PG8_SA(0, 0), cA, voffA); PG8_STAGE(PG8_SB(0, 1), cB + hstep, voffB); PG8_STAGE(PG8_SA(0, 1), cA + hstep, voffA);
        if (wr == 1) PG8_BAR;
        PG8_WAIT_V(4); PG8_BAR;
        PG8_STAGE(PG8_SB(1, 0), cB + kstep, voffB); PG8_STAGE(PG8_SA(1, 0), cA + kstep, voffA); PG8_STAGE(PG8_SB(1, 1), cB + hstep + kstep, voffB);
        PG8_WAIT_V(6); PG8_BAR;
    }
    for (;;) {
        const bool has_next = S.next(ui + 1, nxt);
        const char* nA = has_next ? (const char*)g.A + (size_t)nxt.pm * tstep : cA; const char* nB = has_next ? (const char*)g.Bt + (size_t)nxt.pn * tstep : cB;
        for (int t = 0; t < nt; t += 2) {
            const bool last = (t == nt - 2);
            const char* a1 = cA + (size_t)(t + 1) * kstep;
            const char* a2 = last ? nA : cA + (size_t)(t + 2) * kstep; const char* b2 = last ? nB : cB + (size_t)(t + 2) * kstep;
            const char* a3 = a2 + kstep; const char* b3 = b2 + kstep;
            if (last && has_next) S.a_ready(nxt);
            if constexpr (SP2) {
            PG8_LDB(B0, 0, 0); PG8_LDB(B1, 0, 1); PG8_SCHED; PG8_LDA(At, 0, 0); PG8_STAGE(PG8_SA(1, 1), a1 + hstep, voffA);
            PG8_WAIT_V(8); PG8_WAIT_L(0); PG8_BAR; PG8_MMA(0, 0, At, B0); PG8_MMA(0, 1, At, B1); PG8_BAR; PG8_SCHED;
            PG8_LDA(At, 0, 1); PG8_STAGE(PG8_SB(0, 0), b2, voffB); PG8_STAGE(PG8_SB(0, 1), b2 + hstep, voffB); PG8_STAGE(PG8_SA(0, 0), a2, voffA);
            PG8_WAIT_V(8); PG8_WAIT_L(0); PG8_BAR; PG8_MMA(1, 0, At, B0); PG8_MMA(1, 1, At, B1); PG8_BAR; PG8_SCHED;
            PG8_LDB(B0, 1, 0); PG8_LDB(B1, 1, 1); PG8_SCHED; PG8_LDA(At, 1, 0); PG8_STAGE(PG8_SA(0, 1), a2 + hstep, voffA);
            PG8_WAIT_V(8); PG8_WAIT_L(0); PG8_BAR; PG8_MMA(0, 0, At, B0); PG8_MMA(0, 1, At, B1); PG8_BAR; PG8_SCHED;
            PG8_LDA(At, 1, 1); PG8_STAGE(PG8_SB(1, 0), b3, voffB); PG8_STAGE(PG8_SB(1, 1), b3 + hstep, voffB); PG8_STAGE(PG8_SA(1, 0), a3, voffA);
            PG8_WAIT_V(8); PG8_WAIT_L(0); PG8_BAR; PG8_MMA(1, 0, At, B0); PG8_MMA(1, 1, At, B1); PG8_BAR; PG8_SCHED;
            } else {
            PG8_LDB(B0, 0, 0); PG8_SCHED; PG8_LDA(At, 0, 0); PG8_STAGE(PG8_SA(1, 1), a1 + hstep, voffA);
            PG8_WAIT_L(8); PG8_BAR; PG8_WAIT_L(0); PG8_MMA(0, 0, At, B0); PG8_BAR; PG8_SCHED;
            PG8_LDB(B1, 0, 1); PG8_STAGE(PG8_SB(0, 0), b2, voffB);
            PG8_BAR; PG8_WAIT_L(0); PG8_MMA(0, 1, At, B1); PG8_BAR;
            PG8_LDA(At, 0, 1); PG8_STAGE(PG8_SA(0, 0), a2, voffA);
            PG8_BAR; PG8_WAIT_L(0); PG8_MMA(1, 0, At, B0); PG8_BAR; PG8_SCHED;
            PG8_STAGE(PG8_SB(0, 1), b2 + hstep, voffB);
            PG8_WAIT_V(6); PG8_BAR; PG8_MMA(1, 1, At, B1); PG8_BAR;
            PG8_LDB(B0, 1, 0); PG8_SCHED; PG8_LDA(At, 1, 0); PG8_STAGE(PG8_SA(0, 1), a2 + hstep, voffA);
            PG8_WAIT_L(8); PG8_BAR; PG8_WAIT_L(0); PG8_MMA(0, 0, At, B0); PG8_BAR; PG8_SCHED;
            PG8_LDB(B1, 1, 1); PG8_STAGE(PG8_SB(1, 0), b3, voffB);
            PG8_BAR; PG8_WAIT_L(0); PG8_MMA(0, 1, At, B1); PG8_BAR;
            PG8_LDA(At, 1, 1); PG8_STAGE(PG8_SA(1, 0), a3, voffA);
            PG8_BAR; PG8_WAIT_L(0); PG8_MMA(1, 0, At, B0); PG8_BAR; PG8_SCHED;
            PG8_STAGE(PG8_SB(1, 1), b3 + hstep, voffB);
            PG8_WAIT_V(6); PG8_BAR; PG8_MMA(1, 1, At, B1); PG8_BAR;
            }
        }
        if constexpr (ALIGN_EPI) { if (wr == 0) PG8_BAR; }
        if constexpr (!Epi::AFTER_DRAIN) { E(acc, cur, wr, wc, fr, fq); S.done(cur); }
        if (!has_next) break;
#pragma unroll
        for (int a = 0; a < 2; ++a)
#pragma unroll
            for (int b = 0; b < 2; ++b)
#pragma unroll
                for (int m = 0; m < 4; ++m)
#pragma unroll
                    for (int n = 0; n < 2; ++n) acc[a][b][m][n] = (f32x4){0.f, 0.f, 0.f, 0.f};
        cur = nxt; cA = nA; cB = nB; ++ui;
        if constexpr (ALIGN_EPI) { if (wr == 1) PG8_BAR; }
    }
    PG8_WAIT_V(0);
    if constexpr (!ALIGN_EPI) { if (wr == 0) PG8_BAR; }
    PG8_BAR;
    if constexpr (Epi::AFTER_DRAIN) { E.fused(acc, cur, wr, wc, fr, fq, lds, wid, lane); S.done(cur); }
#undef PG8_SA
#undef PG8_SB
#undef PG8_STAGE
#undef PG8_LDA
#undef PG8_LDB
#undef PG8_MMA
#undef PG8_WAIT_V
#undef PG8_WAIT_L
#undef PG8_BAR
#undef PG8_SCHED
}
}
#ifndef PG8_SP2
#define PG8_SP2 true
#endif
#ifndef PG8_ALIGN
#define PG8_ALIGN true
#endif
namespace att {
using bf16 = __hip_bfloat16;
constexpr int   D = 128, NW = 8, QBLK = 32, KVBLK = 64;
constexpr float SCALE = 0.088388347648318440f;
constexpr float THR = 8.f;
constexpr int SDEPTH = 2;
constexpr int LDQ = 4608, LDK = 4608, LDO = 1024;
constexpr size_t SHM_V = KVBLK * D * 2, SHM_K = KVBLK * D * 2, SHM_ATTN = 2 * SHM_V + 2 * SHM_K + NW * 64 * 4;
using bf16x8 = __attribute__((ext_vector_type(8))) short;
using s16x4  = __attribute__((ext_vector_type(4))) short;
using f32x16 = __attribute__((ext_vector_type(16))) float;
using f32x8  = __attribute__((ext_vector_type(8))) float;
using u32x4  = __attribute__((ext_vector_type(4))) unsigned;
#define KSWZ(row, colB) ((row) * 256 + ((colB) ^ (((row) & 7) << 4)))
#define SBAR() __builtin_amdgcn_sched_barrier(0)
__device__ __forceinline__ int crow(int r, int hi) { return (r & 3) + 8 * (r >> 2) + 4 * hi; }
__device__ __forceinline__ unsigned cvtpk(float lo, float hi) {
  unsigned r; asm volatile("v_cvt_pk_bf16_f32 %0, %1, %2" : "=v"(r) : "v"(lo), "v"(hi)); return r;
}
template <typename TIn> struct Stage;
template <> struct Stage<bf16>  { using T = bf16x8;
  __device__ static __forceinline__ T ld8(const bf16* p) { return *reinterpret_cast<const bf16x8*>(p); }
  __device__ static __forceinline__ bf16x8 tobf(T x) { return x; } };
template <> struct Stage<float> { using T = f32x8;
  __device__ static __forceinline__ T ld8(const float* p) { return *reinterpret_cast<const f32x8*>(p); }
  __device__ static __forceinline__ bf16x8 tobf(T x) {
    u32x4 w = {cvtpk(x[0], x[1]), cvtpk(x[2], x[3]), cvtpk(x[4], x[5]), cvtpk(x[6], x[7])}; return *reinterpret_cast<bf16x8*>(&w); } };

__device__ __forceinline__ void partialSM(f32x16& p0, f32x16& p1, float& m_reg, float& mn, float& alpha) {
  constexpr float C = SCALE * 1.4426950408889634f;
  float pmax = p0[0]; for (int r = 1; r < 16; ++r) pmax = fmaxf(pmax, p0[r]); for (int r = 0; r < 16; ++r) pmax = fmaxf(pmax, p1[r]);
  { auto rr = __builtin_amdgcn_permlane32_swap(__float_as_uint(pmax), __float_as_uint(pmax), false, false);
    pmax = fmaxf(__uint_as_float(rr[0]), __uint_as_float(rr[1])); }
  if (__builtin_expect(__all(pmax - m_reg <= THR / SCALE), 1)) { mn = m_reg; alpha = 1.f; }
  else { mn = fmaxf(m_reg, pmax); alpha = __builtin_amdgcn_exp2f((m_reg - mn) * C); m_reg = mn; }
  float mnC = -mn * C;
  for (int r = 0; r < 16; ++r) p0[r] = fmaf(p0[r], C, mnC); for (int r = 0; r < 16; ++r) p1[r] = fmaf(p1[r], C, mnC);
  for (int r = 0; r < 16; ++r) p0[r] = __builtin_amdgcn_exp2f(p0[r]);
}
__device__ __forceinline__ void finishSM(f32x16& p0, f32x16& p1, float alpha, float& l_reg, bf16x8& pa0, bf16x8& pa1, bf16x8& pa2, bf16x8& pa3) {
  for (int r = 0; r < 16; ++r) p1[r] = __builtin_amdgcn_exp2f(p1[r]);
  float ps = 0; for (int r = 0; r < 16; ++r) ps += p0[r]; for (int r = 0; r < 16; ++r) ps += p1[r];
  { auto rr = __builtin_amdgcn_permlane32_swap(__float_as_uint(ps), __float_as_uint(ps), false, false);
    ps = __uint_as_float(rr[0]) + __uint_as_float(rr[1]); }
  l_reg = l_reg * alpha + ps;
#define PK4(P, BASE, OUT) do { unsigned a0 = cvtpk(P[BASE + 0], P[BASE + 1]), a1 = cvtpk(P[BASE + 2], P[BASE + 3]);   \
    unsigned b0 = cvtpk(P[BASE + 4], P[BASE + 5]), b1 = cvtpk(P[BASE + 6], P[BASE + 7]);                              \
    auto r0 = __builtin_amdgcn_permlane32_swap(a0, b0, false, false); auto r1 = __builtin_amdgcn_permlane32_swap(a1, b1, false, false); \
    u32x4 w = {r0[0], r1[0], r0[1], r1[1]}; OUT = *reinterpret_cast<bf16x8*>(&w); } while (0)
  PK4(p0, 0, pa0); PK4(p0, 8, pa1); PK4(p1, 0, pa2); PK4(p1, 8, pa3);
#undef PK4
}
__device__ __forceinline__ void qkt(f32x16& p0, f32x16& p1, const bf16* Ks, const bf16x8* qr, int r32, int hi) {
  p0 = f32x16{}; p1 = f32x16{};
  for (int d0 = 0; d0 < 8; ++d0) { int cb = (d0 * 16 + hi * 8) * 2;
    bf16x8 b0 = *reinterpret_cast<const bf16x8*>((const char*)Ks + KSWZ(r32, cb));
    bf16x8 b1 = *reinterpret_cast<const bf16x8*>((const char*)Ks + KSWZ(32 + r32, cb));
    p0 = __builtin_amdgcn_mfma_f32_32x32x16_bf16(b0, qr[d0], p0, 0, 0, 0);
    p1 = __builtin_amdgcn_mfma_f32_32x32x16_bf16(b1, qr[d0], p1, 0, 0, 0); }
}
__device__ __forceinline__ int v_st(int k, int c) { const int kk = (k & ~0xC) | ((k & 4) << 1) | ((k & 8) >> 1); return ((kk >> 3) * 4 + (c >> 5)) * 512 + ((kk & 7) * 32 + (c & 31)) * 2; }
__device__ __forceinline__ int v_rd_base(int lane) { return ((lane & 3) << 3) | (((lane >> 2) & 3) << 6) | (((lane >> 4) & 1) << 5) | (((lane >> 5) & 1) << 8); }
constexpr int v_rd_off(int d0, int ks, int half) { return d0 * 512 + ks * 4096 + half * 2048; }
template <int OFF> __device__ __forceinline__ s16x4 tr_read(int vb) {
  s16x4 r; asm volatile("ds_read_b64_tr_b16 %0, %1 offset:%2" : "=&v"(r) : "v"(vb), "i"(OFF) : "memory"); return r;
}
template <int D0> __device__ __forceinline__ void pv_one(f32x16& od, int vb, bf16x8 pa0, bf16x8 pa1, bf16x8 pa2, bf16x8 pa3) {
  const s16x4 l0 = tr_read<v_rd_off(D0, 0, 0)>(vb), h0 = tr_read<v_rd_off(D0, 0, 1)>(vb), l1 = tr_read<v_rd_off(D0, 1, 0)>(vb), h1 = tr_read<v_rd_off(D0, 1, 1)>(vb);
  const s16x4 l2 = tr_read<v_rd_off(D0, 2, 0)>(vb), h2 = tr_read<v_rd_off(D0, 2, 1)>(vb), l3 = tr_read<v_rd_off(D0, 3, 0)>(vb), h3 = tr_read<v_rd_off(D0, 3, 1)>(vb);
  asm volatile("s_waitcnt lgkmcnt(0)" ::: "memory"); SBAR();
#define PK(L, H) (bf16x8){L[0], L[1], L[2], L[3], H[0], H[1], H[2], H[3]}
  od = __builtin_amdgcn_mfma_f32_32x32x16_bf16(pa0, PK(l0, h0), od, 0, 0, 0);
  od = __builtin_amdgcn_mfma_f32_32x32x16_bf16(pa1, PK(l1, h1), od, 0, 0, 0);
  od = __builtin_amdgcn_mfma_f32_32x32x16_bf16(pa2, PK(l2, h2), od, 0, 0, 0);
  od = __builtin_amdgcn_mfma_f32_32x32x16_bf16(pa3, PK(l3, h3), od, 0, 0, 0);
#undef PK
}
__device__ __forceinline__ void pv_d0(f32x16* o, int vb, bf16x8 pa0, bf16x8 pa1, bf16x8 pa2, bf16x8 pa3) {
  pv_one<0>(o[0], vb, pa0, pa1, pa2, pa3); pv_one<1>(o[1], vb, pa0, pa1, pa2, pa3); pv_one<2>(o[2], vb, pa0, pa1, pa2, pa3); pv_one<3>(o[3], vb, pa0, pa1, pa2, pa3);
}

template <typename TQ>
__device__ __forceinline__ void attn_dense_body(const TQ* __restrict__ Qb, const bf16* __restrict__ Kh, const bf16* __restrict__ Vh,
                                                float* __restrict__ Ob, int seq, char* lds, const int tid) {
  using St = Stage<bf16>; using SQ = Stage<TQ>;
  const int wid = tid >> 6, lane = tid & 63, r32 = lane & 31, hi = lane >> 5;
  bf16* V_lds = (bf16*)lds; bf16* K_lds = (bf16*)(lds + 2 * SHM_V);
  float* ws = (float*)(lds + 2 * SHM_V + 2 * SHM_K) + wid * 64; float* li_l = ws; float* al_l = ws + 32;
  float m_reg = -1e30f, l_reg = 0; f32x16 o[4] = {}; bf16x8 qr[8];
  const TQ* Qw = Qb + (long)(wid * QBLK + r32) * LDQ + hi * 8;
#pragma unroll
  for (int d0 = 0; d0 < 8; ++d0) qr[d0] = SQ::tobf(SQ::ld8(Qw + d0 * 16));
  const int sr = tid >> 4, sc = (tid & 15) * 8, vst0 = v_st(sr, sc), vst1 = v_st(32 + sr, sc);
  const int vb0 = (int)(uintptr_t)V_lds + v_rd_base(lane);
  struct { typename St::T vs0, vs1, ks0, ks1; } sr_[SDEPTH];
#define SLOAD(i, k0) do { sr_[i].vs0 = St::ld8(&Vh[(long)((k0) + sr) * LDK + sc]); sr_[i].vs1 = St::ld8(&Vh[(long)((k0) + 32 + sr) * LDK + sc]); \
    sr_[i].ks0 = St::ld8(&Kh[(long)((k0) + sr) * LDK + sc]); sr_[i].ks1 = St::ld8(&Kh[(long)((k0) + 32 + sr) * LDK + sc]); } while (0)
#define SWRITE(b, i) do { *(bf16x8*)((char*)V_lds + (b) * SHM_V + vst0) = St::tobf(sr_[i].vs0);          \
    *(bf16x8*)((char*)V_lds + (b) * SHM_V + vst1) = St::tobf(sr_[i].vs1); int kc = sc * 2;               \
    *(bf16x8*)((char*)K_lds + (b) * SHM_K + KSWZ(sr, kc)) = St::tobf(sr_[i].ks0);                       \
    *(bf16x8*)((char*)K_lds + (b) * SHM_K + KSWZ(32 + sr, kc)) = St::tobf(sr_[i].ks1); } while (0)
#define SWAIT() do { if constexpr (SDEPTH == 2) asm volatile("s_waitcnt vmcnt(4)" ::: "memory"); else asm volatile("s_waitcnt vmcnt(0)" ::: "memory"); } while (0)
#define RESC(a) do { if (__any((a) < 1.f)) { if (hi == 0) al_l[r32] = (a); asm volatile("s_waitcnt lgkmcnt(0)" ::: "memory"); \
    for (int d = 0; d < 4; ++d) for (int r = 0; r < 16; ++r) o[d][r] *= al_l[crow(r, hi)]; } } while (0)
  f32x16 pA0, pA1, pB0, pB1; float mnA, mnB, alA, alB; bf16x8 pa0, pa1, pa2, pa3; const int NT = seq / KVBLK;
  constexpr int SE = 0, SO = SDEPTH - 1;
  SLOAD(SE, 0); asm volatile("s_waitcnt vmcnt(0)" ::: "memory"); SWRITE(0, SE); __syncthreads();
  qkt(pA0, pA1, K_lds, qr, r32, hi); partialSM(pA0, pA1, m_reg, mnA, alA);
  SLOAD(SO, KVBLK); if constexpr (SDEPTH == 2) { if (2 < NT) SLOAD(SE, 2 * KVBLK); }
  SWAIT(); SWRITE(1, SO); __syncthreads();
  for (int j = 1; j + 1 < NT; j += 2) {
    SBAR(); qkt(pB0, pB1, (bf16*)((char*)K_lds + SHM_K), qr, r32, hi);
    finishSM(pA0, pA1, alA, l_reg, pa0, pa1, pa2, pa3); SBAR();
    SLOAD(SO, (j + SDEPTH) * KVBLK); SBAR();
    pv_d0(o, vb0, pa0, pa1, pa2, pa3); partialSM(pB0, pB1, m_reg, mnB, alB);
    __syncthreads(); SWAIT(); SWRITE(0, SE);
    RESC(alB); __syncthreads();
    SBAR(); qkt(pA0, pA1, K_lds, qr, r32, hi);
    finishSM(pB0, pB1, alB, l_reg, pa0, pa1, pa2, pa3); SBAR();
    if (SDEPTH == 1 || j + 3 < NT) SLOAD(SE, (j + 1 + SDEPTH) * KVBLK); SBAR();
    pv_d0(o, vb0 + (int)SHM_V, pa0, pa1, pa2, pa3); partialSM(pA0, pA1, m_reg, mnA, alA);
    __syncthreads(); SWAIT(); SWRITE(1, SO);
    RESC(alA); __syncthreads();
  }
  SBAR(); qkt(pB0, pB1, (bf16*)((char*)K_lds + SHM_K), qr, r32, hi);
  finishSM(pA0, pA1, alA, l_reg, pa0, pa1, pa2, pa3); SBAR();
  pv_d0(o, vb0, pa0, pa1, pa2, pa3); partialSM(pB0, pB1, m_reg, mnB, alB);
  __syncthreads(); RESC(alB);
  finishSM(pB0, pB1, alB, l_reg, pa0, pa1, pa2, pa3); SBAR();
  pv_d0(o, vb0 + (int)SHM_V, pa0, pa1, pa2, pa3);
  if (hi == 0) li_l[r32] = l_reg; asm volatile("s_waitcnt lgkmcnt(0)" ::: "memory");
  float rli[16];
#pragma unroll
  for (int r = 0; r < 16; ++r) rli[r] = __builtin_amdgcn_rcpf(li_l[crow(r, hi)]);
  float* Ow = Ob + (long)(wid * QBLK) * LDO;
#pragma unroll
  for (int r = 0; r < 16; ++r) { int orow = crow(r, hi);
    for (int d0 = 0; d0 < 4; ++d0) Ow[(long)orow * LDO + d0 * 32 + r32] = o[d0][r] * rli[r]; }
#undef SLOAD
#undef SWRITE
#undef SWAIT
#undef RESC
}
}

#ifndef MK_N_LAUNCHES
#define MK_N_LAUNCHES 1
#endif
constexpr int NWAVES = 8, NTHR = 512;
constexpr int NPHASES = 22;
constexpr int L = 8192, DM = 2048, DIN = 4608, AW = 1024, HWD = 1024, DFF = 5504, NUP = 11008, NFFT = 16384, DEPTH = 2;
constexpr int C_K = 1024, C_V = 1280, C_HY = 1536;
constexpr float ALPHA = 1.4142135623730951f;
constexpr float LN_EPS = 1e-5f, RMS_EPS = 1e-6f;
constexpr size_t MiB = 1u << 20;
constexpr size_t WS_CTL = 0, CTL_ZERO_BYTES = 1 * MiB;
constexpr size_t WS_TWID = 1 * MiB;
constexpr size_t WS_ROPE = 1 * MiB + 128 * 1024;
constexpr size_t WS_HID2 = 2 * MiB;
constexpr size_t WS_WIN = 8 * MiB, WIN_STRIDE = (size_t)DIN * DM * 2;
constexpr size_t WS_WOUT = 44 * MiB, WOUT_STRIDE = (size_t)DM * DM * 2;
constexpr size_t WS_WUP = 60 * MiB, WUP_STRIDE = (size_t)NUP * DM * 2;
constexpr size_t WS_WDN = 146 * MiB, WDN_STRIDE = (size_t)DM * DFF * 2;
constexpr size_t WS_KAB = 190 * MiB, KAB_STRIDE = 64 * MiB;
constexpr size_t WS_XN = 318 * MiB;
constexpr size_t WS_S = 350 * MiB;
constexpr size_t WS_PROJ = WS_S, WS_X0 = WS_S + 72 * MiB, WS_ZT = WS_S + 88 * MiB, WS_YT = WS_S + 120 * MiB, WS_AO = WS_S + 152 * MiB, WS_MIXA = WS_S + 184 * MiB;
constexpr size_t WS_UP = WS_S, WS_G = WS_S + 172 * MiB, WS_END = WS_S + 258 * MiB;
static_assert(WS_WIN + 2 * WIN_STRIDE <= WS_WOUT && WS_WOUT + 2 * WOUT_STRIDE <= WS_WUP && WS_WUP + 2 * WUP_STRIDE <= WS_WDN && WS_WDN + 2 * WDN_STRIDE <= WS_KAB, "weights map");
static_assert((size_t)L * DIN * 2 <= 72 * MiB && (size_t)L * NUP * 2 <= 172 * MiB && (size_t)L * DFF * 2 <= 86 * MiB, "scratch map");
constexpr int CW_BAR = 4096;
constexpr int RING_BYTES = 131072, EXTRA_OFF = 131072, LDSCTL_OFF = 131072 + 8192, MISC_OFF = LDSCTL_OFF + 320, LDS_BYTES = 147456;

#define GAS __attribute__((address_space(1)))
#define LAS __attribute__((address_space(3)))
typedef unsigned short bf16;
typedef unsigned v4u __attribute__((ext_vector_type(4)));
typedef unsigned v2u __attribute__((ext_vector_type(2)));
typedef float f32x4 __attribute__((ext_vector_type(4)));
typedef float f2 __attribute__((ext_vector_type(2)));
typedef GAS unsigned gu32;
#define LDS_WAIT() asm volatile("s_waitcnt lgkmcnt(0)" ::: "memory")
#define VM_WAIT() asm volatile("s_waitcnt vmcnt(0)" ::: "memory")
__device__ __forceinline__ unsigned f2bf(float f) { unsigned u = __builtin_bit_cast(unsigned, f); return (u + 0x7fffu + ((u >> 16) & 1u)) >> 16; }
__device__ __forceinline__ unsigned pk2(float lo, float hi) { return f2bf(lo) | (f2bf(hi) << 16); }
__device__ __forceinline__ float bflo(unsigned w) { return __builtin_bit_cast(float, w << 16); }
__device__ __forceinline__ float bfhi(unsigned w) { return __builtin_bit_cast(float, w & 0xffff0000u); }
__device__ __forceinline__ float bf1(unsigned short h) { return __builtin_bit_cast(float, (unsigned)h << 16); }

#define XB_TMO      128
#define XB_XCNT(j)  (256  + 64 * (j))
#define XB_XSUB(j)  (1280 + 64 * (j))
#define XB_XGEN(j)  (2304 + 64 * (j))
#define XB_TOP      3328
#define XB_TOPGEN   3392
#define XCD_BAR_WORDS 3456
#define XB_SPIN_CAP (1u << 18)
__device__ __forceinline__ unsigned xb_ld(unsigned* p)              { return __hip_atomic_load(p, __ATOMIC_RELAXED, __HIP_MEMORY_SCOPE_AGENT); }
__device__ __forceinline__ unsigned xb_add(unsigned* p, unsigned v) { return __hip_atomic_fetch_add(p, v, __ATOMIC_RELAXED, __HIP_MEMORY_SCOPE_AGENT); }
__device__ __forceinline__ unsigned xb_xcc_id() { return (unsigned)__builtin_amdgcn_s_getreg((3 << 11) | 20) & 0xFu; }
#define XB_SPIN(cond, bar) do { unsigned _sp = 0; while (cond) { __builtin_amdgcn_s_sleep(1); \
    if ((++_sp & 255u) == 0u) { if (xb_ld(&(bar)[XB_TMO])) break; if (_sp > XB_SPIN_CAP) { atomicAdd(&(bar)[XB_TMO], 1u); break; } } } } while (0)
struct XcdBarrier { unsigned* bar; unsigned x; volatile LAS unsigned* st; };
__device__ __forceinline__ XcdBarrier xcd_barrier_post(unsigned* bar, volatile LAS unsigned* st) {
    XcdBarrier b; b.bar = bar; b.x = xb_xcc_id(); b.st = st;
    if (threadIdx.x == 0) (void)xb_add(&bar[XB_XCNT(b.x)], 1u);
    return b;
}
__device__ __forceinline__ void xcd_barrier_complete(unsigned* bar, unsigned x, unsigned& nloc, unsigned& nx) {
    const unsigned G = gridDim.x * gridDim.y * gridDim.z;
    unsigned sum, cnt, mine, sp = 0u;
    for (;;) {
        sum = 0u; cnt = 0u; mine = 0u;
#pragma unroll
        for (unsigned j = 0; j < 16; ++j) { const unsigned c = xb_ld(&bar[XB_XCNT(j)]); sum += c; cnt += (c > 0u) ? 1u : 0u; mine = (j == x) ? c : mine; }
        if (sum == G) break;
        __builtin_amdgcn_s_sleep(1);
        if ((++sp & 255u) == 0u) { if (xb_ld(&bar[XB_TMO])) break; if (sp > XB_SPIN_CAP) { atomicAdd(&bar[XB_TMO], 1u); break; } }
    }
    nloc = mine > 0u ? mine : 1u; nx = cnt > 0u ? cnt : 1u;
}
__device__ __forceinline__ void xcd_barrier(const XcdBarrier& b) {
    asm volatile("s_waitcnt vmcnt(0)" ::: "memory");
    __syncthreads();
    if (threadIdx.x == 0) {
        unsigned* bar = b.bar;
        __builtin_amdgcn_s_waitcnt(0);
        unsigned nloc = b.st[0], nx = b.st[1];
        if (nloc == 0u) { xcd_barrier_complete(bar, b.x, nloc, nx); b.st[0] = nloc; b.st[1] = nx; }
        const unsigned old = xb_add(&bar[XB_XSUB(b.x)], 1u);
        const unsigned gen = old / nloc;
        if (old + 1u == (gen + 1u) * nloc) {
            __builtin_amdgcn_fence(__ATOMIC_RELEASE, "agent");
            asm volatile("s_waitcnt vmcnt(0)" ::: "memory");
            const unsigned og = xb_add(&bar[XB_TOP], 1u);
            const unsigned tg = og / nx;
            if (og + 1u == (tg + 1u) * nx) xb_add(&bar[XB_TOPGEN], 1u);
            else XB_SPIN(xb_ld(&bar[XB_TOPGEN]) == tg, bar);
            __builtin_amdgcn_fence(__ATOMIC_ACQUIRE, "agent");
            xb_add(&bar[XB_XGEN(b.x)], 1u);
            asm volatile("s_waitcnt vmcnt(0)" ::: "memory");
        } else {
            XB_SPIN(xb_ld(&bar[XB_XGEN(b.x)]) == gen, bar);
            __builtin_amdgcn_fence(__ATOMIC_ACQUIRE, "agent");
            asm volatile("s_waitcnt vmcnt(0)" ::: "memory");
        }
    }
    __syncthreads();
}

struct Frame {
    LAS unsigned char* lds;
    volatile LAS unsigned* MISC;
    int tid, lane, wave, G, bid;
    unsigned char* ws;
};
__device__ __forceinline__ float wave_sum(float v) {
#pragma unroll
    for (int o = 1; o < 64; o <<= 1) v += __shfl_xor(v, o);
    return v;
}
__device__ __forceinline__ float block_sum(float v, LAS float* red, int wave, int lane) {
    v = wave_sum(v);
    __syncthreads();
    if (lane == 0) red[wave] = v;
    __syncthreads();
    float s = 0.f;
#pragma unroll
    for (int w = 0; w < NWAVES; ++w) s += red[w];
    return s;
}

__device__ __forceinline__ void p0_transpose_item(const float* W, int K, int N, bf16* WT, LAS float* scr, int item, int lane) {
    const int nblk = N / 32, kb = item / nblk, nb = item % nblk, k0 = 64 * kb, n0 = 32 * nb;
#pragma unroll 8
    for (int i = 0; i < 32; ++i) { const int kk = 2 * i + (lane >> 5); scr[kk * 33 + (lane & 31)] = W[(size_t)(k0 + kk) * N + n0 + (lane & 31)]; }
    LDS_WAIT(); asm volatile("" ::: "memory");
    const int c = lane & 7;
#pragma unroll
    for (int j = 0; j < 4; ++j) { const int n = (lane >> 3) + 8 * j; const LAS float* s = scr + (8 * c) * 33 + n;
        v4u o; o.x = pk2(s[0 * 33], s[1 * 33]); o.y = pk2(s[2 * 33], s[3 * 33]); o.z = pk2(s[4 * 33], s[5 * 33]); o.w = pk2(s[6 * 33], s[7 * 33]);
        *(GAS v4u*)(WT + (size_t)(n0 + n) * K + k0 + 8 * c) = o; }
    LDS_WAIT(); asm volatile("" ::: "memory");
}
__device__ __forceinline__ void ln_row(const float* xin, const float* g, const float* b, float* xout, bf16* xn, int lane) {
    const f32x4* xr = (const f32x4*)xin + lane;
    f32x4 v[8]; float s = 0.f;
#pragma unroll
    for (int j = 0; j < 8; ++j) { v[j] = xr[64 * j]; s += (v[j].x + v[j].y) + (v[j].z + v[j].w); }
    const float mean = wave_sum(s) * (1.f / DM); float s2 = 0.f;
#pragma unroll
    for (int j = 0; j < 8; ++j) { v[j] = v[j] - mean; s2 += (v[j].x * v[j].x + v[j].y * v[j].y) + (v[j].z * v[j].z + v[j].w * v[j].w); }
    const float rstd = 1.f / sqrtf(wave_sum(s2) * (1.f / DM) + LN_EPS);
    f32x4* xo = (f32x4*)xout + lane; v2u* o8 = (v2u*)xn + lane;
#pragma unroll
    for (int j = 0; j < 8; ++j) { const f32x4 gv = ((const f32x4*)g)[64 * j + lane], bv = ((const f32x4*)b)[64 * j + lane];
        const f32x4 o = v[j] * rstd * gv + bv; xo[64 * j] = o; v2u w; w.x = pk2(o.x, o.y); w.y = pk2(o.z, o.w); o8[64 * j] = w; }
}

__device__ __forceinline__ f2 cmul(f2 a, f2 b) { return (f2){a.x * b.x - a.y * b.y, a.x * b.y + a.y * b.x}; }
__device__ __forceinline__ int rev4(int p) { const unsigned x = __brev((unsigned)p) >> 18; return (int)(((x & 0x1555u) << 1) | ((x >> 1) & 0x1555u)); }
template <int LQ> __device__ __forceinline__ void fft_pass_fwd(LAS f2* X, const f2* TW, int tid) {
    constexpr int q = 1 << LQ, n = 4 * q, tws = NFFT / n;
#pragma unroll 2
    for (int i = 0; i < 8; ++i) {
        const int b = tid + NTHR * i, blk = b >> LQ, j = b & (q - 1), base = blk * n + j;
        const f2 a0 = X[base], a1 = X[base + q], a2 = X[base + 2 * q], a3 = X[base + 3 * q];
        const f2 t0 = a0 + a2, t1 = a0 - a2, t2 = a1 + a3, d = a1 - a3; const f2 t3 = (f2){d.y, -d.x};
        f2 y0 = t0 + t2, y1 = t1 + t3, y2 = t0 - t2, y3 = t1 - t3;
        if (LQ > 0) { const f2 w1 = TW[j * tws], w2 = cmul(w1, w1), w3 = cmul(w2, w1); y1 = cmul(y1, w1); y2 = cmul(y2, w2); y3 = cmul(y3, w3); }
        X[base] = y0; X[base + q] = y1; X[base + 2 * q] = y2; X[base + 3 * q] = y3;
    }
    __syncthreads();
}
template <int LQ> __device__ __forceinline__ void fft_pass_inv(LAS f2* X, const f2* TW, int tid) {
    constexpr int q = 1 << LQ, n = 4 * q, tws = NFFT / n;
#pragma unroll 2
    for (int i = 0; i < 8; ++i) {
        const int b = tid + NTHR * i, blk = b >> LQ, j = b & (q - 1), base = blk * n + j;
        f2 u0 = X[base], u1 = X[base + q], u2 = X[base + 2 * q], u3 = X[base + 3 * q];
        if (LQ > 0) { f2 w1 = TW[j * tws]; w1.y = -w1.y; const f2 w2 = cmul(w1, w1), w3 = cmul(w2, w1); u1 = cmul(u1, w1); u2 = cmul(u2, w2); u3 = cmul(u3, w3); }
        const f2 t0 = u0 + u2, t1 = u0 - u2, t2 = u1 + u3, d = u1 - u3; const f2 t3 = (f2){-d.y, d.x};
        X[base] = t0 + t2; X[base + q] = t1 + t3; X[base + 2 * q] = t0 - t2; X[base + 3 * q] = t1 - t3;
    }
    __syncthreads();
}
__device__ __forceinline__ void fft_fwd(LAS f2* X, const f2* TW, int tid) {
    fft_pass_fwd<12>(X, TW, tid); fft_pass_fwd<10>(X, TW, tid); fft_pass_fwd<8>(X, TW, tid); fft_pass_fwd<6>(X, TW, tid);
    fft_pass_fwd<4>(X, TW, tid); fft_pass_fwd<2>(X, TW, tid); fft_pass_fwd<0>(X, TW, tid);
}
__device__ __forceinline__ void fft_inv(LAS f2* X, const f2* TW, int tid) {
    fft_pass_inv<0>(X, TW, tid); fft_pass_inv<2>(X, TW, tid); fft_pass_inv<4>(X, TW, tid); fft_pass_inv<6>(X, TW, tid);
    fft_pass_inv<8>(X, TW, tid); fft_pass_inv<10>(X, TW, tid); fft_pass_inv<12>(X, TW, tid);
}
__device__ __forceinline__ int pw_freq(int wave, int i, int lane) { return ((lane & 31) << 8) | ((wave * 16 + i) << 1) | (lane >> 5); }

struct FiltIn { const float* w3; const float* b3; const float* decay; };
__device__ __forceinline__ void kab_unit(const Frame& F, const FiltIn fi, int l, int pr) {
    LAS f2* X = (LAS f2*)F.lds;
    LAS float* wsub = (LAS float*)(F.lds + EXTRA_OFF);
    LAS float* red = (LAS float*)(F.lds + EXTRA_OFF + 1024);
    const f2* TW = (const f2*)(F.ws + WS_TWID);
    const float* hid = (const float*)(F.ws + WS_HID2) + (size_t)l * L * 64;
    const int c0 = 2 * pr, tid = F.tid;
    if (tid < 256) { const int j = tid >> 2, q = tid & 3; wsub[tid] = fi.w3[((size_t)l * 64 + j) * 2048 + (q >> 1) * 1024 + c0 + (q & 1)]; }
    float b3v[4], dec[4];
#pragma unroll
    for (int q = 0; q < 4; ++q) { b3v[q] = fi.b3[l * 2048 + (q >> 1) * 1024 + c0 + (q & 1)]; dec[q] = fabsf(fi.decay[(l * 2 + (q >> 1)) * 1024 + c0 + (q & 1)]); }
    __syncthreads();
    float sa = 0.f, sb = 0.f;
#pragma unroll 1
    for (int i = 0; i < 16; ++i) {
        const int t = tid + NTHR * i; const f32x4* row = (const f32x4*)(hid + (size_t)t * 64);
        float a0 = b3v[0], a1 = b3v[1], a2 = b3v[2], a3 = b3v[3];
#pragma unroll 4
        for (int j4 = 0; j4 < 16; ++j4) { const f32x4 h = row[j4];
#pragma unroll
            for (int e = 0; e < 4; ++e) { const f32x4 w = *(const LAS f32x4*)(wsub + (4 * j4 + e) * 4); a0 += h[e] * w.x; a1 += h[e] * w.y; a2 += h[e] * w.z; a3 += h[e] * w.w; } }
        const float tl = (float)t * (1.0f / (float)(L - 1));
        a0 *= expf(-tl * dec[0]); a1 *= expf(-tl * dec[1]); a2 *= expf(-tl * dec[2]); a3 *= expf(-tl * dec[3]);
        sa += fabsf(a0) + fabsf(a2); sb += fabsf(a1) + fabsf(a3);
        X[t] = (f2){a0, a1};
        if (t >= 1) X[NFFT - t] = (f2){a2, a3};
    }
    sa = block_sum(sa, red, F.wave, F.lane); sb = block_sum(sb, red, F.wave, F.lane);
    const float ka = 1.0f / (sa * (float)NFFT), kb = 1.0f / (sb * (float)NFFT);
#pragma unroll 2
    for (int i = 0; i < 16; ++i) {
        const int t = tid + NTHR * i;
        f2 v = X[t]; v.x *= ka; v.y *= kb; X[t] = v;
        if (t >= 1) { f2 w = X[NFFT - t]; w.x *= ka; w.y *= kb; X[NFFT - t] = w; }
    }
    if (tid == 0) X[L] = (f2){0.f, 0.f};
    __syncthreads();
    fft_fwd(X, TW, tid);
    f32x4* KAB = (f32x4*)(F.ws + WS_KAB + (size_t)l * KAB_STRIDE) + (size_t)pr * 8192;
#pragma unroll 2
    for (int i = 0; i < 16; ++i) {
        const int k = pw_freq(F.wave, i, F.lane), idx = (i * 8 + F.wave) * 64 + F.lane;
        f32x4 o;
        if (k == 0) { const f2 k0 = X[0], kh = X[rev4(NFFT / 2)]; o = (f32x4){k0.x, kh.x, k0.y, kh.y}; }
        else { const f2 K1 = X[rev4(k)], K2 = X[rev4(NFFT - k)];
            o = (f32x4){0.5f * (K1.x + K2.x), 0.5f * (K1.y - K2.y), 0.5f * (K1.y + K2.y), -0.5f * (K1.x - K2.x)}; }
        KAB[idx] = o;
    }
    __syncthreads();
}

__device__ __forceinline__ void conv_unit(const Frame& F, const float* skip, int l, int pr) {
    LAS f2* X = (LAS f2*)F.lds;
    const f2* TW = (const f2*)(F.ws + WS_TWID);
    const int c0 = 2 * pr, tid = F.tid;
    const float* za = (const float*)(F.ws + WS_ZT) + (size_t)c0 * L; const float* zb = za + L;
#pragma unroll 4
    for (int i = 0; i < 16; ++i) { const int t = tid + NTHR * i; X[t] = (f2){za[t], zb[t]}; X[L + t] = (f2){0.f, 0.f}; }
    __syncthreads();
    fft_fwd(X, TW, tid);
    const f32x4* KAB = (const f32x4*)(F.ws + WS_KAB + (size_t)l * KAB_STRIDE) + (size_t)pr * 8192;
#pragma unroll 2
    for (int i = 0; i < 16; ++i) {
        const int k = pw_freq(F.wave, i, F.lane), idx = (i * 8 + F.wave) * 64 + F.lane;
        const f32x4 kv = KAB[idx];
        if (k == 0) { const int ph = rev4(NFFT / 2); const f2 x0 = X[0], xh = X[ph]; X[0] = (f2){x0.x * kv.x, x0.y * kv.z}; X[ph] = (f2){xh.x * kv.y, xh.y * kv.w}; }
        else { const int p = rev4(k), pp = rev4(NFFT - k); const f2 X1 = X[p], X2 = X[pp];
            const f2 A = (f2){0.5f * (X1.x + X2.x), 0.5f * (X1.y - X2.y)}, B = (f2){0.5f * (X1.y + X2.y), -0.5f * (X1.x - X2.x)};
            const f2 P = cmul(A, (f2){kv.x, kv.y}), Q = cmul(B, (f2){kv.z, kv.w});
            X[p] = (f2){P.x - Q.y, P.y + Q.x}; X[pp] = (f2){P.x + Q.y, Q.x - P.y}; }
    }
    __syncthreads();
    fft_inv(X, TW, tid);
    const float ska = skip[l * HWD + c0], skb = skip[l * HWD + c0 + 1];
    float* ya = (float*)(F.ws + WS_YT) + (size_t)c0 * L; float* yb = ya + L;
#pragma unroll 4
    for (int i = 0; i < 16; ++i) { const int t = tid + NTHR * i; const f2 y = X[t]; ya[t] = y.x + ska * za[t]; yb[t] = y.y + skb * zb[t]; }
    __syncthreads();
}

struct Args { const float* in[32]; float* out; unsigned char* ws; int ph_lo, ph_hi; };
enum { I_X = 0, I_LNIN_G, I_LNIN_B, I_WIN, I_QG, I_KG, I_HCW, I_HCB, I_FW1, I_FB1, I_FF1, I_FW2, I_FB2, I_FF2, I_FW3, I_FB3, I_DECAY, I_SKIP, I_AOG, I_HOG, I_WOUT, I_BOUT,
       I_LN1G, I_LN1B, I_WUP, I_BUP, I_FCW, I_FCB, I_WDN, I_BDN, I_LN2G, I_LN2B };

__global__ void __launch_bounds__(NTHR, 2) mk_fwd(Args args) {
    extern __shared__ __attribute__((aligned(16))) unsigned char lds[];
    volatile LAS unsigned* const MISCp = (volatile LAS unsigned*)((LAS unsigned char*)lds + MISC_OFF);
    unsigned char* const ws0 = args.ws;
    for (int u = threadIdx.x; u < (LDS_BYTES - LDSCTL_OFF) / 4; u += NTHR) ((LAS unsigned*)((LAS unsigned char*)lds + LDSCTL_OFF))[u] = 0u;
    __syncthreads();
    XcdBarrier bar; bar.bar = (unsigned*)(ws0 + WS_CTL) + CW_BAR; bar.x = 0; bar.st = nullptr;
    if (MK_N_LAUNCHES == 1) bar = xcd_barrier_post((unsigned*)(ws0 + WS_CTL) + CW_BAR, MISCp + 8);
    const int lo = args.ph_lo, hi = args.ph_hi;
#ifdef DBG_ONLY
#define INP(k) ((k) == DBG_ONLY && lo <= (k) && (k) < hi)
#define INL(o) ((o) + 2 == DBG_ONLY && lo <= P + (o) && P + (o) < hi)
#else
#define INP(k) (lo <= (k) && (k) < hi)
#define INL(o) (lo <= P + (o) && P + (o) < hi)
#endif
#define SEAMK(k) do { if (lo <= (k) && (k) + 1 < hi) xcd_barrier(bar); } while (0)
#define KAS __attribute__((address_space(4)))
#define PF(LV) int tid_ = threadIdx.x, l_ = (LV), bid_ = blockIdx.x; const KAS unsigned char* ka_ = (const KAS unsigned char*)__builtin_amdgcn_kernarg_segment_ptr(); \
    asm volatile("" : "+v"(tid_), "+s"(l_), "+s"(bid_), "+s"(ka_)); \
    unsigned char* const ws = *(unsigned char* const KAS*)(ka_ + 264); float* const XF = *(float* const KAS*)(ka_ + 256); bf16* const XN = (bf16*)(ws + WS_XN); \
    Frame F; F.lds = (LAS unsigned char*)lds; F.MISC = MISCp; F.tid = tid_; F.lane = tid_ & 63; F.wave = __builtin_amdgcn_readfirstlane(tid_ >> 6); F.G = gridDim.x; F.bid = bid_; F.ws = ws; \
    const int l = l_; const int gw = F.bid * NWAVES + F.wave, NGW = F.G * NWAVES, gtid = F.bid * NTHR + F.tid, NGT = F.G * NTHR; (void)l; (void)gw; (void)NGW; (void)gtid; (void)NGT; (void)XF; (void)XN;
#define AIN(i) (*(const float* const KAS*)(ka_ + 8 * (i)))

    if (INP(0)) { PF(0);
        LAS float* scr = (LAS float*)(F.lds + F.wave * 16384);
        constexpr int I_IN = (DM / 64) * (DIN / 32), I_OUT = (DM / 64) * (DM / 32), I_UP = (DM / 64) * (NUP / 32), I_DN = (DFF / 64) * (DM / 32), I_LAYER = I_IN + I_OUT + I_UP + I_DN;
        for (int it = gw; it < DEPTH * I_LAYER; it += NGW) {
            const int l = it / I_LAYER; int r = it % I_LAYER;
            if (r < I_IN) { p0_transpose_item(AIN(I_WIN) + (size_t)l * DM * DIN, DM, DIN, (bf16*)(ws + WS_WIN + l * WIN_STRIDE), scr, r, F.lane); continue; } r -= I_IN;
            if (r < I_OUT) { p0_transpose_item(AIN(I_WOUT) + (size_t)l * DM * DM, DM, DM, (bf16*)(ws + WS_WOUT + l * WOUT_STRIDE), scr, r, F.lane); continue; } r -= I_OUT;
            if (r < I_UP) { p0_transpose_item(AIN(I_WUP) + (size_t)l * DM * NUP, DM, NUP, (bf16*)(ws + WS_WUP + l * WUP_STRIDE), scr, r, F.lane); continue; } r -= I_UP;
            p0_transpose_item(AIN(I_WDN) + (size_t)l * DFF * DM, DFF, DM, (bf16*)(ws + WS_WDN + l * WDN_STRIDE), scr, r, F.lane);
        }
        for (int m = gw; m < L; m += NGW) ln_row(AIN(I_X) + (size_t)m * DM, AIN(I_LNIN_G), AIN(I_LNIN_B), XF + (size_t)m * DM, XN + (size_t)m * DM, F.lane);
        for (int k = gtid; k < NFFT; k += NGT) { double s, c; sincospi(2.0 * (double)k / (double)NFFT, &s, &c); ((f2*)(ws + WS_TWID))[k] = (f2){(float)c, (float)(-s)}; }
        for (int e = gtid; e < 128 * 32; e += NGT) { const int p = e >> 5, i = e & 31; const double th = pow(10000.0, -(double)i / 32.0), ang = (double)p * th; ((f2*)(ws + WS_ROPE))[e] = (f2){(float)cos(ang), (float)sin(ang)}; }
        for (int it = gw; it < DEPTH * L; it += NGW) {
            const int l = it / L, t = it % L, lane = F.lane;
            const float* w1 = AIN(I_FW1) + l * 33 * 64; const float* w2 = AIN(I_FW2) + l * 64 * 64;
            const double wt = 6.283185307179586476925 * (double)t / (double)L, fb = 1e-4 + (double)(lane & 15) * ((15.0 - 1e-4) / 15.0);
            double sn, cs; sincos(fb * wt, &sn, &cs);
            const float cz = (float)cs, sz = (float)(-sn);
            float a = AIN(I_FB1)[l * 64 + lane] + ((float)t * (1.0f / (float)(L - 1))) * w1[lane];
#pragma unroll
            for (int i = 0; i < 16; ++i) a += __shfl(cz, i) * w1[(1 + i) * 64 + lane];
#pragma unroll
            for (int i = 0; i < 16; ++i) a += __shfl(sz, i) * w1[(17 + i) * 64 + lane];
            const float h1 = sinf(AIN(I_FF1)[l * 64 + lane] * a);
            float a2 = AIN(I_FB2)[l * 64 + lane];
#pragma unroll 8
            for (int i = 0; i < 64; ++i) a2 += __shfl(h1, i) * w2[i * 64 + lane];
            ((float*)(ws + WS_HID2))[((size_t)l * L + t) * 64 + lane] = sinf(AIN(I_FF2)[l * 64 + lane] * a2);
        }
    }
    SEAMK(0);
    if (INP(1)) { PF(0);
        const FiltIn fi{AIN(I_FW3), AIN(I_FB3), AIN(I_DECAY)};
        for (int u = F.bid; u < DEPTH * 512; u += F.G) kab_unit(F, fi, u >> 9, u & 511);
    }
    SEAMK(1);

    for (int lv = 0; lv < DEPTH; ++lv) {
        const int P = 2 + 10 * lv;
        if (INL(0)) { PF(lv); bf16* const PROJ = (bf16*)(ws + WS_PROJ); (void)PROJ;
            pg8::Gemm g{XN, (const bf16*)(ws + WS_WIN + l * WIN_STRIDE), L, DIN, DM}; pg8::StaticOrder S; S.init(L, DIN, F.G, F.bid);
            pg8::EpiBf16<0> E{PROJ, DIN, nullptr, 0, 0, 1.f};
            pg8::gemm_phase<pg8::EpiBf16<0>, pg8::StaticOrder, PG8_ALIGN, PG8_SP2>(F.lds, g, S, E, F.tid);
        }
        SEAMK(P + 0);
        if (INL(1)) { PF(lv); bf16* const PROJ = (bf16*)(ws + WS_PROJ); (void)PROJ;
            const f2* ROPE = (const f2*)(ws + WS_ROPE);
            const float* qg = AIN(I_QG) + l * 128; const float* kg = AIN(I_KG) + l * 128;
            for (int it = gw; it < L * 160 / 64; it += NGW) {
                const int g = it * 64 + F.lane, t = g / 160, cc = g % 160, head = cc >> 4, sub = cc & 15;
                bf16* p = PROJ + (size_t)t * DIN + cc * 8;
                const v4u raw = *(const v4u*)p;
                float v[8] = {bflo(raw.x), bfhi(raw.x), bflo(raw.y), bfhi(raw.y), bflo(raw.z), bfhi(raw.z), bflo(raw.w), bfhi(raw.w)};
                float ss = 0.f;
#pragma unroll
                for (int e = 0; e < 8; ++e) ss += v[e] * v[e];
                ss += __shfl_xor(ss, 1); ss += __shfl_xor(ss, 2); ss += __shfl_xor(ss, 4); ss += __shfl_xor(ss, 8);
                const float rinv = 1.0f / sqrtf(ss * (1.0f / 128.0f) + RMS_EPS);
                const float* gp = (head < 8 ? qg : kg) + sub * 8;
                const int pos = (sub < 8) ? (t >> 6) : (t & 63), sub8 = sub & 7;
                const f2* rp = ROPE + pos * 32 + (sub8 & 3) * 8;
                float o[8];
#pragma unroll
                for (int e = 0; e < 8; ++e) v[e] = v[e] * rinv * gp[e];
#pragma unroll
                for (int e = 0; e < 8; ++e) { const float pv = __shfl_xor(v[e], 4); const f2 cs = rp[e]; o[e] = (sub8 < 4) ? (v[e] * cs.x - pv * cs.y) : (v[e] * cs.x + pv * cs.y); }
                v4u w; w.x = pk2(o[0], o[1]); w.y = pk2(o[2], o[3]); w.z = pk2(o[4], o[5]); w.w = pk2(o[6], o[7]);
                *(v4u*)p = w;
            }
            LAS float* scr = (LAS float*)(F.lds + F.wave * 16384);
            const float* cw = AIN(I_HCW) + (size_t)l * 3 * 3072; const float* cb = AIN(I_HCB) + (size_t)l * 3072;
            bf16* X0 = (bf16*)(ws + WS_X0); float* ZT = (float*)(ws + WS_ZT);
            for (int it = gw; it < (L / 32) * (HWD / 64); it += NGW) {
                const int tb = it / (HWD / 64), cbk = it % (HWD / 64), t0 = tb * 32, c = cbk * 64 + F.lane;
                float w0[3], w1[3], w2[3], bb[3], um[3], uc[3], un[3];
#pragma unroll
                for (int gI = 0; gI < 3; ++gI) { const int col = gI * 1024 + c; w0[gI] = cw[col]; w1[gI] = cw[3072 + col]; w2[gI] = cw[2 * 3072 + col]; bb[gI] = cb[col];
                    const bf16* up = PROJ + C_HY + col;
                    um[gI] = (t0 > 0) ? bf1(up[(size_t)(t0 - 1) * DIN]) : 0.f; uc[gI] = bf1(up[(size_t)t0 * DIN]); }
                for (int tt = 0; tt < 32; ++tt) {
                    const int t = t0 + tt;
                    float r[3];
#pragma unroll
                    for (int gI = 0; gI < 3; ++gI) { const bf16* up = PROJ + C_HY + gI * 1024 + c;
                        un[gI] = (t + 1 < L) ? bf1(up[(size_t)(t + 1) * DIN]) : 0.f;
                        r[gI] = w0[gI] * um[gI] + w1[gI] * uc[gI] + w2[gI] * un[gI] + bb[gI]; um[gI] = uc[gI]; uc[gI] = un[gI]; }
                    X0[(size_t)t * HWD + c] = (bf16)f2bf(r[0]);
                    scr[tt * 65 + F.lane] = r[1] * r[2];
                }
                LDS_WAIT(); asm volatile("" ::: "memory");
#pragma unroll 4
                for (int i = 0; i < 32; ++i) { const int cl = 2 * i + (F.lane >> 5), tt = F.lane & 31; ZT[(size_t)(cbk * 64 + cl) * L + t0 + tt] = scr[tt * 65 + cl]; }
                LDS_WAIT(); asm volatile("" ::: "memory");
            }
        }
        SEAMK(P + 1);
        if (INL(2)) { PF(lv); bf16* const PROJ = (bf16*)(ws + WS_PROJ); (void)PROJ;
#ifndef DBG_NOATT
            for (int u = F.bid; u < 256; u += F.G) {
                const int x = u & 7, qb = u >> 3, kvh = x >> 2, hq = x;
                const att::bf16* Q = (const att::bf16*)PROJ + (size_t)(qb * 256) * DIN + hq * 128;
                const att::bf16* Kp = (const att::bf16*)PROJ + C_K + kvh * 128;
                const att::bf16* Vp = (const att::bf16*)PROJ + C_V + kvh * 128;
                float* O = (float*)(ws + WS_AO) + (size_t)(qb * 256) * AW + hq * 128;
                att::attn_dense_body<att::bf16>(Q, Kp, Vp, O, L, (char*)lds, F.tid);
                __syncthreads();
            }
#endif
#ifndef DBG_NOCONV
            for (int u = F.bid; u < 512; u += F.G) conv_unit(F, AIN(I_SKIP), l, u);
#endif
        }
        SEAMK(P + 2);
        if (INL(3)) { PF(lv); bf16* const PROJ = (bf16*)(ws + WS_PROJ); (void)PROJ;
            LAS float* T = (LAS float*)F.lds;
            const float* YT = (const float*)(ws + WS_YT); const float* AO = (const float*)(ws + WS_AO); const bf16* X0 = (const bf16*)(ws + WS_X0);
            bf16* MIXA = (bf16*)(ws + WS_MIXA);
            const float* ag = AIN(I_AOG) + l * AW; const float* hg = AIN(I_HOG) + l * HWD;
            for (int it = F.bid; it < L / 16; it += F.G) {
                const int t0 = it * 16;
#pragma unroll
                for (int h = 0; h < 2; ++h) { const int c = F.tid + NTHR * h; const f32x4* src = (const f32x4*)(YT + (size_t)c * L + t0);
#pragma unroll
                    for (int q = 0; q < 4; ++q) { const f32x4 v = src[q]; T[c * 17 + 4 * q] = v.x; T[c * 17 + 4 * q + 1] = v.y; T[c * 17 + 4 * q + 2] = v.z; T[c * 17 + 4 * q + 3] = v.w; } }
                __syncthreads();
#pragma unroll
                for (int s = 0; s < 2; ++s) {
                    const int tt = 2 * F.wave + s, t = t0 + tt;
                    f32x4 a[4]; float ss = 0.f;
#pragma unroll
                    for (int j = 0; j < 4; ++j) { a[j] = ((const f32x4*)(AO + (size_t)t * AW))[64 * j + F.lane]; ss += (a[j].x * a[j].x + a[j].y * a[j].y) + (a[j].z * a[j].z + a[j].w * a[j].w); }
                    const float ra = 1.0f / sqrtf(wave_sum(ss) * (1.0f / AW) + RMS_EPS);
#pragma unroll
                    for (int j = 0; j < 4; ++j) { const f32x4 gv = ((const f32x4*)ag)[64 * j + F.lane]; const f32x4 o = a[j] * ra * gv;
                        v2u w; w.x = pk2(o.x, o.y); w.y = pk2(o.z, o.w); ((v2u*)(MIXA + (size_t)t * DM))[64 * j + F.lane] = w; }
                    float h0[8], h1[8]; float sh = 0.f;
#pragma unroll
                    for (int k = 0; k < 8; ++k) { const int c = 2 * F.lane + 128 * k; const unsigned xw = *(const unsigned*)(X0 + (size_t)t * HWD + c);
                        h0[k] = bflo(xw) * T[c * 17 + tt]; h1[k] = bfhi(xw) * T[(c + 1) * 17 + tt]; sh += h0[k] * h0[k] + h1[k] * h1[k]; }
                    const float rh = 1.0f / sqrtf(wave_sum(sh) * (1.0f / HWD) + RMS_EPS);
#pragma unroll
                    for (int k = 0; k < 8; ++k) { const int c = 2 * F.lane + 128 * k; const f2 gv = *(const f2*)(hg + c);
                        *(unsigned*)(MIXA + (size_t)t * DM + AW + c) = pk2(h0[k] * rh * gv.x, h1[k] * rh * gv.y); }
                }
                __syncthreads();
            }
        }
        SEAMK(P + 3);
        if (INL(4)) { PF(lv); bf16* const PROJ = (bf16*)(ws + WS_PROJ); (void)PROJ;
            pg8::Gemm g{(const bf16*)(ws + WS_MIXA), (const bf16*)(ws + WS_WOUT + l * WOUT_STRIDE), L, DM, DM}; pg8::StaticOrder S; S.init(L, DM, F.G, F.bid);
            pg8::EpiResid E{XF, DM, AIN(I_BOUT) + l * DM, ALPHA};
            pg8::gemm_phase<pg8::EpiResid, pg8::StaticOrder, PG8_ALIGN, PG8_SP2>(F.lds, g, S, E, F.tid);
        }
        SEAMK(P + 4);
        if (INL(5)) { PF(lv); bf16* const PROJ = (bf16*)(ws + WS_PROJ); (void)PROJ; for (int m = gw; m < L; m += NGW) ln_row(XF + (size_t)m * DM, AIN(I_LN1G) + l * DM, AIN(I_LN1B) + l * DM, XF + (size_t)m * DM, XN + (size_t)m * DM, F.lane); }
        SEAMK(P + 5);
        if (INL(6)) { PF(lv); bf16* const PROJ = (bf16*)(ws + WS_PROJ); (void)PROJ;
            pg8::Gemm g{XN, (const bf16*)(ws + WS_WUP + l * WUP_STRIDE), L, NUP, DM}; pg8::StaticOrder S; S.init(L, NUP, F.G, F.bid);
            pg8::EpiBf16<0> E{(bf16*)(ws + WS_UP), NUP, AIN(I_BUP) + (size_t)l * NUP, 0, 0, 1.f};
            pg8::gemm_phase<pg8::EpiBf16<0>, pg8::StaticOrder, PG8_ALIGN, PG8_SP2>(F.lds, g, S, E, F.tid);
        }
        SEAMK(P + 6);
        if (INL(7)) { PF(lv); bf16* const PROJ = (bf16*)(ws + WS_PROJ); (void)PROJ;
            const bf16* UP = (const bf16*)(ws + WS_UP); bf16* Gb = (bf16*)(ws + WS_G);
            const float* fw = AIN(I_FCW) + (size_t)l * 3 * DFF; const float* fb = AIN(I_FCB) + (size_t)l * DFF;
            constexpr int NCC = DFF / 8;
            for (int it = gtid; it < (L / 16) * NCC; it += NGT) {
                const int cc = it % NCC, tb = it / NCC, j0 = cc * 8, t0 = tb * 16;
                float w0[8], w1[8], w2[8], bb[8], pv[8], cv[8], nv[8];
#pragma unroll
                for (int h = 0; h < 2; ++h) { const f32x4 a = *(const f32x4*)(fw + j0 + 4 * h), b = *(const f32x4*)(fw + DFF + j0 + 4 * h), c = *(const f32x4*)(fw + 2 * DFF + j0 + 4 * h), d = *(const f32x4*)(fb + j0 + 4 * h);
#pragma unroll
                    for (int e = 0; e < 4; ++e) { w0[4 * h + e] = a[e]; w1[4 * h + e] = b[e]; w2[4 * h + e] = c[e]; bb[4 * h + e] = d[e]; } }
                { v4u r = (v4u){0u, 0u, 0u, 0u}; if (t0 > 0) r = *(const v4u*)(UP + (size_t)(t0 - 1) * NUP + j0);
                  pv[0] = bflo(r.x); pv[1] = bfhi(r.x); pv[2] = bflo(r.y); pv[3] = bfhi(r.y); pv[4] = bflo(r.z); pv[5] = bfhi(r.z); pv[6] = bflo(r.w); pv[7] = bfhi(r.w);
                  r = *(const v4u*)(UP + (size_t)t0 * NUP + j0);
                  cv[0] = bflo(r.x); cv[1] = bfhi(r.x); cv[2] = bflo(r.y); cv[3] = bfhi(r.y); cv[4] = bflo(r.z); cv[5] = bfhi(r.z); cv[6] = bflo(r.w); cv[7] = bfhi(r.w); }
                for (int tt = 0; tt < 16; ++tt) {
                    const int t = t0 + tt;
                    v4u r = (v4u){0u, 0u, 0u, 0u}; if (t + 1 < L) r = *(const v4u*)(UP + (size_t)(t + 1) * NUP + j0);
                    nv[0] = bflo(r.x); nv[1] = bfhi(r.x); nv[2] = bflo(r.y); nv[3] = bfhi(r.y); nv[4] = bflo(r.z); nv[5] = bfhi(r.z); nv[6] = bflo(r.w); nv[7] = bfhi(r.w);
                    const v4u vr = *(const v4u*)(UP + (size_t)t * NUP + DFF + j0);
                    const float vv[8] = {bflo(vr.x), bfhi(vr.x), bflo(vr.y), bfhi(vr.y), bflo(vr.z), bfhi(vr.z), bflo(vr.w), bfhi(vr.w)};
                    float o[8];
#pragma unroll
                    for (int e = 0; e < 8; ++e) { const float x = w0[e] * pv[e] + w1[e] * cv[e] + w2[e] * nv[e] + bb[e];
                        const float u2 = 1.5957691216057308f * (x + 0.044715f * x * x * x);
                        o[e] = x * __builtin_amdgcn_rcpf(1.0f + __expf(-u2)) * vv[e]; pv[e] = cv[e]; cv[e] = nv[e]; }
                    v4u w; w.x = pk2(o[0], o[1]); w.y = pk2(o[2], o[3]); w.z = pk2(o[4], o[5]); w.w = pk2(o[6], o[7]);
                    *(v4u*)(Gb + (size_t)t * DFF + j0) = w;
                }
            }
        }
        SEAMK(P + 7);
        if (INL(8)) { PF(lv); bf16* const PROJ = (bf16*)(ws + WS_PROJ); (void)PROJ;
            pg8::Gemm g{(const bf16*)(ws + WS_G), (const bf16*)(ws + WS_WDN + l * WDN_STRIDE), L, DM, DFF}; pg8::StaticOrder S; S.init(L, DM, F.G, F.bid);
            pg8::EpiResid E{XF, DM, AIN(I_BDN) + l * DM, ALPHA};
            pg8::gemm_phase<pg8::EpiResid, pg8::StaticOrder, PG8_ALIGN, PG8_SP2>(F.lds, g, S, E, F.tid);
        }
        SEAMK(P + 8);
        if (INL(9)) { PF(lv); bf16* const PROJ = (bf16*)(ws + WS_PROJ); (void)PROJ; for (int m = gw; m < L; m += NGW) ln_row(XF + (size_t)m * DM, AIN(I_LN2G) + l * DM, AIN(I_LN2B) + l * DM, XF + (size_t)m * DM, XN + (size_t)m * DM, F.lane); }
        if (lv + 1 < DEPTH) SEAMK(P + 9);
    }
#undef PF
#undef AIN
#undef INP
#undef INL
#undef SEAMK
}

extern "C" void kernel_launch(void* const* d_in, const int* in_sizes, int n_in, void* d_out, int out_size, void* d_ws, size_t ws_size, hipStream_t stream) {
    static int grid = 0;
    if (grid == 0) {
        if (n_in != 32 || in_sizes[0] != L * DM || out_size != L * DM || ws_size < WS_END) {
            fprintf(stderr, "kernel_launch: built for 32 inputs, x/out of %d floats, >= %zu bytes of workspace; got n_in %d, in0 %d, out %d, ws %zu; nothing launched\n", L * DM, (size_t)WS_END, n_in, n_in > 0 ? in_sizes[0] : -1, out_size, ws_size);
            grid = -1; return; }
        int dev = 0, cus = 0, per_cu = 0;
        if (hipGetDevice(&dev) != hipSuccess || hipDeviceGetAttribute(&cus, hipDeviceAttributeMultiprocessorCount, dev) != hipSuccess) { fprintf(stderr, "kernel_launch: device query failed\n"); grid = -1; return; }
        if (hipFuncSetAttribute((const void*)mk_fwd, hipFuncAttributeMaxDynamicSharedMemorySize, LDS_BYTES) != hipSuccess) { fprintf(stderr, "kernel_launch: hipFuncSetAttribute failed\n"); grid = -1; return; }
        if (hipOccupancyMaxActiveBlocksPerMultiprocessor(&per_cu, (const void*)mk_fwd, NTHR, LDS_BYTES) != hipSuccess || per_cu < 1)
            fprintf(stderr, "kernel_launch: note: occupancy query reports %d workgroups per CU\n", per_cu);
        (void)hipGetLastError();
        grid = cus;
    }
    if (grid < 0) return;
    if (hipMemsetAsync((char*)d_ws + WS_CTL, 0, CTL_ZERO_BYTES, stream) != hipSuccess) { fprintf(stderr, "kernel_launch: hipMemsetAsync failed\n"); return; }
    Args a{};
    for (int i = 0; i < 32; ++i) a.in[i] = (const float*)d_in[i];
    a.out = (float*)d_out; a.ws = (unsigned char*)d_ws;
#if MK_N_LAUNCHES == 1
    a.ph_lo = 0; a.ph_hi = NPHASES;
    hipLaunchKernelGGL(mk_fwd, dim3(grid), dim3(NTHR), LDS_BYTES, stream, a);
#else
    for (int p = 0; p < NPHASES; ++p) { a.ph_lo = p; a.ph_hi = p + 1; hipLaunchKernelGGL(mk_fwd, dim3(grid), dim3(NTHR), LDS_BYTES, stream, a); }
#endif
    const hipError_t le = hipPeekAtLastError();
    if (le != hipSuccess) fprintf(stderr, "kernel_launch: launch failed: %s\n", hipGetErrorName(le));
}
```

```cpp
#include <hip/hip_runtime.h>
#include <hip/hip_bf16.h>
#include <cstdio>
#include <cstdint>
#include <cmath>
namespace pg8 {
#define PG8_LAS __attribute__((address_space(3)))
typedef unsigned short bf16_t;
typedef short bf16x8 __attribute__((ext_vector_type(8)));
typedef float f32x4 __attribute__((ext_vector_type(4)));
typedef unsigned u32x4 __attribute__((ext_vector_type(4)));
constexpr int BM = 256, BK = 64, HALF = 128, HTB = HALF * BK * 2  , STAGE_BYTES = 8 * HTB, NXCD = 8, WGM = 8;

__host__ __device__ __forceinline__ int lds_byte(int r, int c) { const int st = (r >> 4) * 2 + (c >> 5), rr = r & 15, cc = c & 31, ob = rr * 64 + cc * 2; return st * 1024 + (ob ^ (((ob >> 9) & 1) << 5)); }
__host__ __device__ __forceinline__ void stage_rc(int b, int& R, int& C) { const int st = b / 1024, sb = b % 1024, swz = sb ^ (((sb >> 9) & 1) << 5); R = (st >> 1) * 16 + swz / 64; C = (st & 1) * 32 + (swz % 64) / 2; }
__host__ __device__ __forceinline__ int perm32(int rho) { const int n = rho >> 4, i = rho & 15; return 8 * (i >> 2) + 4 * n + (i & 3); }

struct Unit { int pm, pn; };
struct Gemm { const bf16_t* A; const bf16_t* Bt; int M, N, K; };

struct StaticOrder {
    int nM, nN, nwg, G, c;
    __host__ __device__ void init(int M, int N, int G_, int c_) { nM = M / BM; nN = N / BM; nwg = nM * nN; G = G_; c = c_; }
    __host__ __device__ bool next(int i, Unit& u) const {
        const long L = (long)i * G + c; if (L >= nwg) return false;
        int wgid = (int)L; { const int q = nwg / NXCD, r = nwg % NXCD, xcd = wgid % NXCD, off = wgid / NXCD; wgid = (xcd < r ? xcd * (q + 1) : r * (q + 1) + (xcd - r) * q) + off; }
        const int nig = WGM * nN, gid = wgid / nig, fm = gid * WGM, gsz = (nM - fm) < WGM ? (nM - fm) : WGM;
        u.pm = fm + ((wgid % nig) % gsz); u.pn = (wgid % nig) / gsz; return true;
    }
    __device__ __forceinline__ void a_ready(const Unit&) const {}
    __device__ __forceinline__ void done(const Unit&) const {}
};

__device__ __forceinline__ unsigned cvt_pk_bf16(float lo, float hi) { unsigned r; asm volatile("v_cvt_pk_bf16_f32 %0, %1, %2" : "=v"(r) : "v"(lo), "v"(hi)); return r; }
typedef float f32x2 __attribute__((ext_vector_type(2)));
__device__ __forceinline__ f32x2 gelu_pk(f32x2 v) {
    const f32x2 av = __builtin_elementwise_abs(v), d = av * 0.2316418882f + 1.0f;
    f32x2 t; t.x = __builtin_amdgcn_rcpf(d.x); t.y = __builtin_amdgcn_rcpf(d.y);
    f32x2 q = t * 0.5307027145f + (-0.7265760135f); q = q * t + 0.7107068705f; q = q * t + (-0.142248368f); q = q * t + 0.127414796f; q = q * t;
    const f32x2 s = (v * v) * (-0.72134752044f);
    f32x2 e; e.x = __builtin_amdgcn_exp2f(s.x); e.y = __builtin_amdgcn_exp2f(s.y);
    const f32x2 m = v * (q * e), r = v - m;
    f32x2 o; o.x = v.x < 0.f ? m.x : r.x; o.y = v.y < 0.f ? m.y : r.y; return o;
}

template <int ACT  > struct EpiBf16 {
    static constexpr bool PERM = true, AFTER_DRAIN = false; static_assert(ACT == 0 || ACT == 1, "EpiBf16: ACT is 0 (none) or 1 (gelu_pk)");
    bf16_t* O; int ldc; const float* bias; int split_cols; size_t split_stride; float scale0;
    __device__ __forceinline__ void operator()(const f32x4 (&acc)[2][2][4][2], const Unit& u, int wr, int wc, int fr, int fq) const {
        const int row0 = u.pm * BM + wr * 64 + fr; int colt = u.pn * BM; bf16_t* base = O;
        float sc = 1.f; if (split_cols) { const int t = colt / split_cols; base += (size_t)t * split_stride; colt -= t * split_cols; if (t == 0) sc = scale0; }
        const int col0 = colt + wc * 32 + 8 * fq, bcol0 = u.pn * BM + wc * 32 + 8 * fq;
        f32x4 bv[2][2];
#pragma unroll
        for (int bj = 0; bj < 2; ++bj)
#pragma unroll
            for (int n = 0; n < 2; ++n) bv[bj][n] = bias ? *(const f32x4*)(bias + bcol0 + bj * HALF + 4 * n) : (f32x4){0.f, 0.f, 0.f, 0.f};
#pragma unroll
        for (int ai = 0; ai < 2; ++ai)
#pragma unroll
            for (int m = 0; m < 4; ++m) { bf16_t* rowp = base + (size_t)(row0 + ai * HALF + m * 16) * ldc + col0;
#pragma unroll
                for (int bj = 0; bj < 2; ++bj) { f32x4 v0 = acc[ai][bj][m][0] + bv[bj][0], v1 = acc[ai][bj][m][1] + bv[bj][1];
                    if (ACT == 1) { f32x2 a = gelu_pk((f32x2){v0[0], v0[1]}), b = gelu_pk((f32x2){v0[2], v0[3]}), c = gelu_pk((f32x2){v1[0], v1[1]}), d = gelu_pk((f32x2){v1[2], v1[3]});
                        v0 = (f32x4){a.x, a.y, b.x, b.y}; v1 = (f32x4){c.x, c.y, d.x, d.y}; }
                    v0 = v0 * sc; v1 = v1 * sc; u32x4 w; w.x = cvt_pk_bf16(v0[0], v0[1]); w.y = cvt_pk_bf16(v0[2], v0[3]); w.z = cvt_pk_bf16(v1[0], v1[1]); w.w = cvt_pk_bf16(v1[2], v1[3]);
                    *(u32x4*)(rowp + bj * HALF) = w; } }
    }
};
struct EpiResid {
    static constexpr bool PERM = false, AFTER_DRAIN = false;
    float* X; int ldc; const float* bias; float alpha;
    __device__ __forceinline__ void operator()(const f32x4 (&acc)[2][2][4][2], const Unit& u, int wr, int wc, int fr, int fq) const {
        const int row0 = u.pm * BM + wr * 64 + fr, col0 = u.pn * BM + wc * 32 + 4 * fq;
        f32x4 bv[2][2];
#pragma unroll
        for (int bj = 0; bj < 2; ++bj)
#pragma unroll
            for (int n = 0; n < 2; ++n) bv[bj][n] = *(const f32x4*)(bias + col0 + bj * HALF + n * 16);
#pragma unroll
        for (int ai = 0; ai < 2; ++ai)
#pragma unroll
            for (int m = 0; m < 4; ++m) { float* rowp = X + (size_t)(row0 + ai * HALF + m * 16) * ldc + col0;
#pragma unroll
                for (int bj = 0; bj < 2; ++bj)
#pragma unroll
                    for (int n = 0; n < 2; ++n) { const f32x4 xv = *(const f32x4*)(rowp + bj * HALF + n * 16); *(f32x4*)(rowp + bj * HALF + n * 16) = xv * alpha + acc[ai][bj][m][n] + bv[bj][n]; }
                asm volatile("" ::: "memory"); }
    }
};
template <class Epi, class Sched, bool ALIGN_EPI = false, bool SP2 = false>
__device__ __forceinline__ void gemm_phase(PG8_LAS unsigned char* lds, const Gemm g, const Sched& S, const Epi& E, const int tid) {
    const int wid = __builtin_amdgcn_readfirstlane(tid >> 6), lane = tid & 63, wr = wid >> 2, wc = wid & 3, fr = lane & 15, fq = lane >> 4;
    const int K = g.K, nt = K / BK;
    unsigned voffA[2], voffB[2];
#pragma unroll
    for (int i = 0; i < 2; ++i) { int R, C; stage_rc(tid * 16 + i * 8192, R, C); const int Rb = Epi::PERM ? ((R & ~31) + perm32(R & 31)) : R;
        voffA[i] = (unsigned)(R * K + C) * 2u; voffB[i] = (unsigned)(Rb * K + C) * 2u; }
    const size_t kstep = (size_t)(BK * 2);
    const size_t hstep = (size_t)HALF * K * 2;
    const size_t tstep = 2 * hstep;
    const unsigned ldsw = (unsigned)wid * 1024u;
    const int aoff = lds_byte(wr * 64 + fr, fq * 8), boff = lds_byte(wc * 32 + fr, fq * 8);
#define PG8_SA(b, h) (((b) * 2 + (h)) * HTB)
#define PG8_SB(b, h) ((4 + (b) * 2 + (h)) * HTB)
#define PG8_STAGE(bufoff, gbase, voff) do { _Pragma("unroll") for (int _i = 0; _i < 2; ++_i) \
        __builtin_amdgcn_global_load_lds((const unsigned*)((const char*)(gbase) + (voff)[_i]), (PG8_LAS unsigned*)(lds + (bufoff) + ldsw + _i * 8192), 16, 0, 0); } while (0)
#define PG8_LDA(dst, b, h) do { _Pragma("unroll") for (int m = 0; m < 4; ++m) _Pragma("unroll") for (int k = 0; k < 2; ++k) dst[m][k] = *(const PG8_LAS bf16x8*)(lds + PG8_SA(b, h) + aoff + m * 2048 + k * 1024); } while (0)
#define PG8_LDB(dst, b, h) do { _Pragma("unroll") for (int n = 0; n < 2; ++n) _Pragma("unroll") for (int k = 0; k < 2; ++k) dst[n][k] = *(const PG8_LAS bf16x8*)(lds + PG8_SB(b, h) + boff + n * 2048 + k * 1024); } while (0)
#define PG8_MMA(ai, bj, At, Bt) do { __builtin_amdgcn_s_setprio(1); _Pragma("unroll") for (int m = 0; m < 4; ++m) _Pragma("unroll") for (int n = 0; n < 2; ++n) _Pragma("unroll") for (int k = 0; k < 2; ++k) \
        acc[ai][bj][m][n] = __builtin_amdgcn_mfma_f32_16x16x32_bf16(Bt[n][k], At[m][k], acc[ai][bj][m][n], 0, 0, 0); __builtin_amdgcn_s_setprio(0); } while (0)
#define PG8_WAIT_V(n) asm volatile("s_waitcnt vmcnt(" #n ")" ::: "memory")
#define PG8_WAIT_L(n) asm volatile("s_waitcnt lgkmcnt(" #n ")" ::: "memory")
#define PG8_BAR __builtin_amdgcn_s_barrier()
#define PG8_SCHED __builtin_amdgcn_sched_barrier(0)
    Unit cur, nxt; int ui = 0;
    if (!S.next(0, cur)) return;
    f32x4 acc[2][2][4][2];
#pragma unroll
    for (int a = 0; a < 2; ++a)
#pragma unroll
        for (int b = 0; b < 2; ++b)
#pragma unroll
            for (int m = 0; m < 4; ++m)
#pragma unroll
                for (int n = 0; n < 2; ++n) acc[a][b][m][n] = (f32x4){0.f, 0.f, 0.f, 0.f};
    bf16x8 At[4][2], B0[2][2], B1[2][2];
    const char* cA = (const char*)g.A + (size_t)cur.pm * tstep; const char* cB = (const char*)g.Bt + (size_t)cur.pn * tstep;
    S.a_ready(cur);
    if constexpr (SP2) {
        PG8_STAGE(PG8_SB(0, 0), cB, voffB); PG8_STAGE(PG8_SB(0, 1), cB + hstep, voffB); PG8_STAGE(PG8_SA(0, 0), cA, voffA); PG8_STAGE(PG8_SA(0, 1), cA + hstep, voffA);
        if (wr == 1) PG8_BAR;
        PG8_WAIT_V(2); PG8_BAR;
        PG8_STAGE(PG8_SB(1, 0), cB + kstep, voffB); PG8_STAGE(PG8_SA(1, 0), cA + kstep, voffA); PG8_STAGE(PG8_SB(1, 1), cB + hstep + kstep, voffB);
        PG8_WAIT_V(6); PG8_BAR;
    } else {
        PG8_STAGE(PG8_SB(0, 0), cB, voffB); PG8_STAGE(PG8_SA(0, 0), cA, voffA); PG8_STAGE(PG8_SB(0, 1), cB + hstep, voffB); PG8_STAGE(PG8_SA(0, 1), cA + hstep, voffA);
        if (wr == 1) PG8_BAR;
        PG8_WAIT_V(4); PG8_BAR;
        PG8_STAGE(PG8_SB(1, 0), cB + kstep, voffB); PG8_STAGE(PG8_SA(1, 0), cA + kstep, voffA); PG8_STAGE(PG8_SB(1, 1), cB + hstep + kstep, voffB);
        PG8_WAIT_V(6); PG8_BAR;
    }
    for (;;) {
        const bool has_next = S.next(ui + 1, nxt);
        const char* nA = has_next ? (const char*)g.A + (size_t)nxt.pm * tstep : cA; const char* nB = has_next ? (const char*)g.Bt + (size_t)nxt.pn * tstep : cB;
        for (int t = 0; t < nt; t += 2) {
            const bool last = (t == nt - 2);
            const char* a1 = cA + (size_t)(t + 1) * kstep;
            const char* a2 = last ? nA : cA + (size_t)(t + 2) * kstep; const char* b2 = last ? nB : cB + (size_t)(t + 2) * kstep;
            const char* a3 = a2 + kstep; const char* b3 = b2 + kstep;
            if (last && has_next) S.a_ready(nxt);
            if constexpr (SP2) {
            PG8_LDB(B0, 0, 0); PG8_LDB(B1, 0, 1); PG8_SCHED; PG8_LDA(At, 0, 0); PG8_STAGE(PG8_SA(1, 1), a1 + hstep, voffA);
            PG8_WAIT_V(8); PG8_WAIT_L(0); PG8_BAR; PG8_MMA(0, 0, At, B0); PG8_MMA(0, 1, At, B1); PG8_BAR; PG8_SCHED;
            PG8_LDA(At, 0, 1); PG8_STAGE(PG8_SB(0, 0), b2, voffB); PG8_STAGE(PG8_SB(0, 1), b2 + hstep, voffB); PG8_STAGE(PG8_SA(0, 0), a2, voffA);
            PG8_WAIT_V(8); PG8_WAIT_L(0); PG8_BAR; PG8_MMA(1, 0, At, B0); PG8_MMA(1, 1, At, B1); PG8_BAR; PG8_SCHED;
            PG8_LDB(B0, 1, 0); PG8_LDB(B1, 1, 1); PG8_SCHED; PG8_LDA(At, 1, 0); PG8_STAGE(PG8_SA(0, 1), a2 + hstep, voffA);
            PG8_WAIT_V(8); PG8_WAIT_L(0); PG8_BAR; PG8_MMA(0, 0, At, B0); PG8_MMA(0, 1, At, B1); PG8_BAR; PG8_SCHED;
            PG8_LDA(At, 1, 1); PG8_STAGE(PG8_SB(1, 0), b3, voffB); PG8_STAGE(PG8_SB(1, 1), b3 + hstep, voffB); PG8_STAGE(PG8_SA(1, 0), a3, voffA);
            PG8_WAIT_V(8); PG8_WAIT_L(0); PG8_BAR; PG8_MMA(1, 0, At, B0); PG8_MMA(1, 1, At, B1); PG8_BAR; PG8_SCHED;
            } else {
            PG8_LDB(B0, 0, 0); PG8_SCHED; PG8_LDA(At, 0, 0); PG8_STAGE(PG8_SA(1, 1), a1 + hstep, voffA);
            PG8_WAIT_L(8); PG8_BAR; PG8_WAIT_L(0); PG8_MMA(0, 0, At, B0); PG8_BAR; PG8_SCHED;
            PG8_LDB(B1, 0, 1); PG8_STAGE(PG8_SB(0, 0), b2, voffB);
            PG8_BAR; PG8_WAIT_L(0); PG8_MMA(0, 1, At, B1); PG8_BAR;
            PG8_LDA(At, 0, 1); PG8_STAGE(PG8_SA(0, 0), a2, voffA);
            PG8_BAR; PG8_WAIT_L(0); PG8_MMA(1, 0, At, B0); PG8_BAR; PG8_SCHED;
            PG8_STAGE(PG8_SB(0, 1), b2 + hstep, voffB);
            PG8_WAIT_V(6); PG8_BAR; PG8_MMA(1, 1, At, B1); PG8_BAR;
            PG8_LDB(B0, 1, 0); PG8_SCHED; PG8_LDA(At, 1, 0); PG8_STAGE(PG8_SA(0, 1), a2 + hstep, voffA);
            PG8_WAIT_L(8); PG8_BAR; PG8_WAIT_L(0); PG8_MMA(0, 0, At, B0); PG8_BAR; PG8_SCHED;
            PG8_LDB(B1, 1, 1); PG8_STAGE(PG8_SB(1, 0), b3, voffB);
            PG8_BAR; PG8_WAIT_L(0); PG8_MMA(0, 1, At, B1); PG8_BAR;
            PG8_LDA(At, 1, 1); PG8_STAGE(PG8_SA(1, 0), a3, voffA);
            PG8_BAR; PG8_WAIT_L(0); PG8_MMA(1, 0, At, B0); PG8_BAR; PG8_SCHED;
            PG8_STAGE(PG8_SB(1, 1), b3 + hstep, voffB);
            PG8_WAIT_V(6); PG8_BAR; PG8_MMA(1, 1, At, B1); PG8_BAR;
            }
        }
        if constexpr (ALIGN_EPI) { if (wr == 0) PG8_BAR; }
        if constexpr (!Epi::AFTER_DRAIN) { E(acc, cur, wr, wc, fr, fq); S.done(cur); }
        if (!has_next) break;
#pragma unroll
        for (int a = 0; a < 2; ++a)
#pragma unroll
            for (int b = 0; b < 2; ++b)
#pragma unroll
                for (int m = 0; m < 4; ++m)
#pragma unroll
                    for (int n = 0; n < 2; ++n) acc[a][b][m][n] = (f32x4){0.f, 0.f, 0.f, 0.f};
        cur = nxt; cA = nA; cB = nB; ++ui;
        if constexpr (ALIGN_EPI) { if (wr == 1) PG8_BAR; }
    }
    PG8_WAIT_V(0);
    if constexpr (!ALIGN_EPI) { if (wr == 0) PG8_BAR; }
    PG8_BAR;
    if constexpr (Epi::AFTER_DRAIN) { E.fused(acc, cur, wr, wc, fr, fq, lds, wid, lane); S.done(cur); }
#undef PG8_SA
#undef PG8_SB
#undef PG8_STAGE
#undef PG8_LDA
#undef PG8_LDB
#undef PG8_MMA
#undef PG8_WAIT_V
#undef PG8_WAIT_L
#undef PG8_BAR
#undef PG8_SCHED
}
}
#ifndef PG8_SP2
#define PG8_SP2 true
#endif
#ifndef PG8_ALIGN
#define PG8_ALIGN true
#endif
namespace att {
using bf16 = __hip_bfloat16;
constexpr int   D = 128, NW = 8, QBLK = 32, KVBLK = 64;
constexpr float SCALE = 0.088388347648318440f;
constexpr float THR = 8.f;
constexpr int SDEPTH = 2;
constexpr int LDQ = 4608, LDK = 4608, LDO = 1024;
constexpr size_t SHM_V = KVBLK * D * 2, SHM_K = KVBLK * D * 2, SHM_ATTN = 2 * SHM_V + 2 * SHM_K + NW * 64 * 4;
using bf16x8 = __attribute__((ext_vector_type(8))) short;
using s16x4  = __attribute__((ext_vector_type(4))) short;
using f32x16 = __attribute__((ext_vector_type(16))) float;
using f32x8  = __attribute__((ext_vector_type(8))) float;
using u32x4  = __attribute__((ext_vector_type(4))) unsigned;
#define KSWZ(row, colB) ((row) * 256 + ((colB) ^ (((row) & 7) << 4)))
#define SBAR() __builtin_amdgcn_sched_barrier(0)
__device__ __forceinline__ int crow(int r, int hi) { return (r & 3) + 8 * (r >> 2) + 4 * hi; }
__device__ __forceinline__ unsigned cvtpk(float lo, float hi) {
  unsigned r; asm volatile("v_cvt_pk_bf16_f32 %0, %1, %2" : "=v"(r) : "v"(lo), "v"(hi)); return r;
}
template <typename TIn> struct Stage;
template <> struct Stage<bf16>  { using T = bf16x8;
  __device__ static __forceinline__ T ld8(const bf16* p) { return *reinterpret_cast<const bf16x8*>(p); }
  __device__ static __forceinline__ bf16x8 tobf(T x) { return x; } };
template <> struct Stage<float> { using T = f32x8;
  __device__ static __forceinline__ T ld8(const float* p) { return *reinterpret_cast<const f32x8*>(p); }
  __device__ static __forceinline__ bf16x8 tobf(T x) {
    u32x4 w = {cvtpk(x[0], x[1]), cvtpk(x[2], x[3]), cvtpk(x[4], x[5]), cvtpk(x[6], x[7])}; return *reinterpret_cast<bf16x8*>(&w); } };

__device__ __forceinline__ void partialSM(f32x16& p0, f32x16& p1, float& m_reg, float& mn, float& alpha) {
  constexpr float C = SCALE * 1.4426950408889634f;
  float pmax = p0[0]; for (int r = 1; r < 16; ++r) pmax = fmaxf(pmax, p0[r]); for (int r = 0; r < 16; ++r) pmax = fmaxf(pmax, p1[r]);
  { auto rr = __builtin_amdgcn_permlane32_swap(__float_as_uint(pmax), __float_as_uint(pmax), false, false);
    pmax = fmaxf(__uint_as_float(rr[0]), __uint_as_float(rr[1])); }
  if (__builtin_expect(__all(pmax - m_reg <= THR / SCALE), 1)) { mn = m_reg; alpha = 1.f; }
  else { mn = fmaxf(m_reg, pmax); alpha = __builtin_amdgcn_exp2f((m_reg - mn) * C); m_reg = mn; }
  float mnC = -mn * C;
  for (int r = 0; r < 16; ++r) p0[r] = fmaf(p0[r], C, mnC); for (int r = 0; r < 16; ++r) p1[r] = fmaf(p1[r], C, mnC);
  for (int r = 0; r < 16; ++r) p0[r] = __builtin_amdgcn_exp2f(p0[r]);
}
__device__ __forceinline__ void finishSM(f32x16& p0, f32x16& p1, float alpha, float& l_reg, bf16x8& pa0, bf16x8& pa1, bf16x8& pa2, bf16x8& pa3) {
  for (int r = 0; r < 16; ++r) p1[r] = __builtin_amdgcn_exp2f(p1[r]);
  float ps = 0; for (int r = 0; r < 16; ++r) ps += p0[r]; for (int r = 0; r < 16; ++r) ps += p1[r];
  { auto rr = __builtin_amdgcn_permlane32_swap(__float_as_uint(ps), __float_as_uint(ps), false, false);
    ps = __uint_as_float(rr[0]) + __uint_as_float(rr[1]); }
  l_reg = l_reg * alpha + ps;
#define PK4(P, BASE, OUT) do { unsigned a0 = cvtpk(P[BASE + 0], P[BASE + 1]), a1 = cvtpk(P[BASE + 2], P[BASE + 3]);   \
    unsigned b0 = cvtpk(P[BASE + 4], P[BASE + 5]), b1 = cvtpk(P[BASE + 6], P[BASE + 7]);                              \
    auto r0 = __builtin_amdgcn_permlane32_swap(a0, b0, false, false); auto r1 = __builtin_amdgcn_permlane32_swap(a1, b1, false, false); \
    u32x4 w = {r0[0], r1[0], r0[1], r1[1]}; OUT = *reinterpret_cast<bf16x8*>(&w); } while (0)
  PK4(p0, 0, pa0); PK4(p0, 8, pa1); PK4(p1, 0, pa2); PK4(p1, 8, pa3);
#undef PK4
}
__device__ __forceinline__ void qkt(f32x16& p0, f32x16& p1, const bf16* Ks, const bf16x8* qr, int r32, int hi) {
  p0 = f32x16{}; p1 = f32x16{};
  for (int d0 = 0; d0 < 8; ++d0) { int cb = (d0 * 16 + hi * 8) * 2;
    bf16x8 b0 = *reinterpret_cast<const bf16x8*>((const char*)Ks + KSWZ(r32, cb));
    bf16x8 b1 = *reinterpret_cast<const bf16x8*>((const char*)Ks + KSWZ(32 + r32, cb));
    p0 = __builtin_amdgcn_mfma_f32_32x32x16_bf16(b0, qr[d0], p0, 0, 0, 0);
    p1 = __builtin_amdgcn_mfma_f32_32x32x16_bf16(b1, qr[d0], p1, 0, 0, 0); }
}
__device__ __forceinline__ int v_st(int k, int c) { const int kk = (k & ~0xC) | ((k & 4) << 1) | ((k & 8) >> 1); return ((kk >> 3) * 4 + (c >> 5)) * 512 + ((kk & 7) * 32 + (c & 31)) * 2; }
__device__ __forceinline__ int v_rd_base(int lane) { return ((lane & 3) << 3) | (((lane >> 2) & 3) << 6) | (((lane >> 4) & 1) << 5) | (((lane >> 5) & 1) << 8); }
constexpr int v_rd_off(int d0, int ks, int half) { return d0 * 512 + ks * 4096 + half * 2048; }
template <int OFF> __device__ __forceinline__ s16x4 tr_read(int vb) {
  s16x4 r; asm volatile("ds_read_b64_tr_b16 %0, %1 offset:%2" : "=&v"(r) : "v"(vb), "i"(OFF) : "memory"); return r;
}
template <int D0> __device__ __forceinline__ void pv_one(f32x16& od, int vb, bf16x8 pa0, bf16x8 pa1, bf16x8 pa2, bf16x8 pa3) {
  const s16x4 l0 = tr_read<v_rd_off(D0, 0, 0)>(vb), h0 = tr_read<v_rd_off(D0, 0, 1)>(vb), l1 = tr_read<v_rd_off(D0, 1, 0)>(vb), h1 = tr_read<v_rd_off(D0, 1, 1)>(vb);
  const s16x4 l2 = tr_read<v_rd_off(D0, 2, 0)>(vb), h2 = tr_read<v_rd_off(D0, 2, 1)>(vb), l3 = tr_read<v_rd_off(D0, 3, 0)>(vb), h3 = tr_read<v_rd_off(D0, 3, 1)>(vb);
  asm volatile("s_waitcnt lgkmcnt(0)" ::: "memory"); SBAR();
#define PK(L, H) (bf16x8){L[0], L[1], L[2], L[3], H[0], H[1], H[2], H[3]}
  od = __builtin_amdgcn_mfma_f32_32x32x16_bf16(pa0, PK(l0, h0), od, 0, 0, 0);
  od = __builtin_amdgcn_mfma_f32_32x32x16_bf16(pa1, PK(l1, h1), od, 0, 0, 0);
  od = __builtin_amdgcn_mfma_f32_32x32x16_bf16(pa2, PK(l2, h2), od, 0, 0, 0);
  od = __builtin_amdgcn_mfma_f32_32x32x16_bf16(pa3, PK(l3, h3), od, 0, 0, 0);
#undef PK
}
__device__ __forceinline__ void pv_d0(f32x16* o, int vb, bf16x8 pa0, bf16x8 pa1, bf16x8 pa2, bf16x8 pa3) {
  pv_one<0>(o[0], vb, pa0, pa1, pa2, pa3); pv_one<1>(o[1], vb, pa0, pa1, pa2, pa3); pv_one<2>(o[2], vb, pa0, pa1, pa2, pa3); pv_one<3>(o[3], vb, pa0, pa1, pa2, pa3);
}

template <typename TQ>
__device__ __forceinline__ void attn_dense_body(const TQ* __restrict__ Qb, const bf16* __restrict__ Kh, const bf16* __restrict__ Vh,
                                                float* __restrict__ Ob, int seq, char* lds, const int tid) {
  using St = Stage<bf16>; using SQ = Stage<TQ>;
  const int wid = tid >> 6, lane = tid & 63, r32 = lane & 31, hi = lane >> 5;
  bf16* V_lds = (bf16*)lds; bf16* K_lds = (bf16*)(lds + 2 * SHM_V);
  float* ws = (float*)(lds + 2 * SHM_V + 2 * SHM_K) + wid * 64; float* li_l = ws; float* al_l = ws + 32;
  float m_reg = -1e30f, l_reg = 0; f32x16 o[4] = {}; bf16x8 qr[8];
  const TQ* Qw = Qb + (long)(wid * QBLK + r32) * LDQ + hi * 8;
#pragma unroll
  for (int d0 = 0; d0 < 8; ++d0) qr[d0] = SQ::tobf(SQ::ld8(Qw + d0 * 16));
  const int sr = tid >> 4, sc = (tid & 15) * 8, vst0 = v_st(sr, sc), vst1 = v_st(32 + sr, sc);
  const int vb0 = (int)(uintptr_t)V_lds + v_rd_base(lane);
  const unsigned loff0 = (unsigned)(sr * LDK + sc), loff1 = (unsigned)((32 + sr) * LDK + sc);
  struct { typename St::T vs0, vs1, ks0, ks1; } sr_[SDEPTH];
#define SLOAD(i, k0) do { const bf16* vt_ = Vh + (size_t)(k0) * LDK; const bf16* kt_ = Kh + (size_t)(k0) * LDK;     \
    sr_[i].vs0 = St::ld8(vt_ + loff0); sr_[i].vs1 = St::ld8(vt_ + loff1); sr_[i].ks0 = St::ld8(kt_ + loff0); sr_[i].ks1 = St::ld8(kt_ + loff1); } while (0)
#define SWRITE(b, i) do { *(bf16x8*)((char*)V_lds + (b) * SHM_V + vst0) = St::tobf(sr_[i].vs0);          \
    *(bf16x8*)((char*)V_lds + (b) * SHM_V + vst1) = St::tobf(sr_[i].vs1); int kc = sc * 2;               \
    *(bf16x8*)((char*)K_lds + (b) * SHM_K + KSWZ(sr, kc)) = St::tobf(sr_[i].ks0);                       \
    *(bf16x8*)((char*)K_lds + (b) * SHM_K + KSWZ(32 + sr, kc)) = St::tobf(sr_[i].ks1); } while (0)
#define SWAIT() do { if constexpr (SDEPTH == 2) asm volatile("s_waitcnt vmcnt(4)" ::: "memory"); else asm volatile("s_waitcnt vmcnt(0)" ::: "memory"); } while (0)
#define RESC(a) do { if (__any((a) < 1.f)) { if (hi == 0) al_l[r32] = (a); asm volatile("s_waitcnt lgkmcnt(0)" ::: "memory"); \
    for (int d = 0; d < 4; ++d) for (int r = 0; r < 16; ++r) o[d][r] *= al_l[crow(r, hi)]; } } while (0)
  f32x16 pA0, pA1, pB0, pB1; float mnA, mnB, alA, alB; bf16x8 pa0, pa1, pa2, pa3; const int NT = seq / KVBLK;
  constexpr int SE = 0, SO = SDEPTH - 1;
  SLOAD(SE, 0); asm volatile("s_waitcnt vmcnt(0)" ::: "memory"); SWRITE(0, SE); __syncthreads();
  qkt(pA0, pA1, K_lds, qr, r32, hi); partialSM(pA0, pA1, m_reg, mnA, alA);
  SLOAD(SO, KVBLK); if constexpr (SDEPTH == 2) { if (2 < NT) SLOAD(SE, 2 * KVBLK); }
  SWAIT(); SWRITE(1, SO); __syncthreads();
  for (int j = 1; j + 1 < NT; j += 2) {
    SBAR(); qkt(pB0, pB1, (bf16*)((char*)K_lds + SHM_K), qr, r32, hi);
    finishSM(pA0, pA1, alA, l_reg, pa0, pa1, pa2, pa3); SBAR();
    SLOAD(SO, (j + SDEPTH) * KVBLK); SBAR();
    pv_d0(o, vb0, pa0, pa1, pa2, pa3); partialSM(pB0, pB1, m_reg, mnB, alB);
    __syncthreads(); SWAIT(); SWRITE(0, SE);
    RESC(alB); __syncthreads();
    SBAR(); qkt(pA0, pA1, K_lds, qr, r32, hi);
    finishSM(pB0, pB1, alB, l_reg, pa0, pa1, pa2, pa3); SBAR();
    if (SDEPTH == 1 || j + 3 < NT) SLOAD(SE, (j + 1 + SDEPTH) * KVBLK); SBAR();
    pv_d0(o, vb0 + (int)SHM_V, pa0, pa1, pa2, pa3); partialSM(pA0, pA1, m_reg, mnA, alA);
    __syncthreads(); SWAIT(); SWRITE(1, SO);
    RESC(alA); __syncthreads();
  }
  SBAR(); qkt(pB0, pB1, (bf16*)((char*)K_lds + SHM_K), qr, r32, hi);
  finishSM(pA0, pA1, alA, l_reg, pa0, pa1, pa2, pa3); SBAR();
  pv_d0(o, vb0, pa0, pa1, pa2, pa3); partialSM(pB0, pB1, m_reg, mnB, alB);
  __syncthreads(); RESC(alB);
  finishSM(pB0, pB1, alB, l_reg, pa0, pa1, pa2, pa3); SBAR();
  pv_d0(o, vb0 + (int)SHM_V, pa0, pa1, pa2, pa3);
  if (hi == 0) li_l[r32] = l_reg; asm volatile("s_waitcnt lgkmcnt(0)" ::: "memory");
  float rli[16];
#pragma unroll
  for (int r = 0; r < 16; ++r) rli[r] = __builtin_amdgcn_rcpf(li_l[crow(r, hi)]);
  float* Ow = Ob + (long)(wid * QBLK) * LDO;
#pragma unroll
  for (int r = 0; r < 16; ++r) { int orow = crow(r, hi);
    for (int d0 = 0; d0 < 4; ++d0) Ow[(long)orow * LDO + d0 * 32 + r32] = o[d0][r] * rli[r]; }
#undef SLOAD
#undef SWRITE
#undef SWAIT
#undef RESC
}
}

#ifndef REP_P0
#define REP_P0 1
#endif
#ifndef REP_P0B
#define REP_P0B 1
#endif
#ifndef REP_BAR
#define REP_BAR 1
#endif
#ifndef REP_P2H
#define REP_P2H 1
#endif
#ifndef REP_G1
#define REP_G1 1
#endif
#ifndef REP_ATT
#define REP_ATT 1
#endif
#ifndef REP_CONV
#define REP_CONV 1
#endif
#ifndef REP_P4
#define REP_P4 1
#endif
#ifndef REP_G7
#define REP_G7 1
#endif
#ifndef REP_P8
#define REP_P8 1
#endif
#ifndef MK_N_LAUNCHES
#define MK_N_LAUNCHES 1
#endif
constexpr int NWAVES = 8, NTHR = 512;
constexpr int NPHASES = 22;
constexpr int L = 8192, DM = 2048, DIN = 4608, AW = 1024, HWD = 1024, DFF = 5504, NUP = 11008, NFFT = 16384, DEPTH = 2;
constexpr int C_K = 1024, C_V = 1280, C_HY = 1536;
constexpr float ALPHA = 1.4142135623730951f;
constexpr float LN_EPS = 1e-5f, RMS_EPS = 1e-6f;
constexpr size_t MiB = 1u << 20;
constexpr size_t WS_CTL = 0, CTL_ZERO_BYTES = 1 * MiB;
constexpr size_t WS_TWID = 1 * MiB;
constexpr size_t WS_ROPE = 1 * MiB + 128 * 1024;
constexpr size_t WS_HID2 = 2 * MiB;
constexpr size_t WS_WIN = 8 * MiB, WIN_STRIDE = (size_t)DIN * DM * 2;
constexpr size_t WS_WOUT = 44 * MiB, WOUT_STRIDE = (size_t)DM * DM * 2;
constexpr size_t WS_WUP = 60 * MiB, WUP_STRIDE = (size_t)NUP * DM * 2;
constexpr size_t WS_WDN = 146 * MiB, WDN_STRIDE = (size_t)DM * DFF * 2;
constexpr size_t WS_KAB = 190 * MiB, KAB_STRIDE = 64 * MiB;
constexpr size_t WS_XN = 318 * MiB;
constexpr size_t WS_S = 350 * MiB;
constexpr size_t WS_PROJ = WS_S, WS_X0 = WS_S + 72 * MiB, WS_ZT = WS_S + 88 * MiB, WS_YT = WS_S + 120 * MiB, WS_AO = WS_S + 152 * MiB, WS_MIXA = WS_S + 184 * MiB;
constexpr size_t WS_UP = WS_S, WS_G = WS_S + 172 * MiB, WS_END = WS_S + 258 * MiB;
static_assert(WS_WIN + 2 * WIN_STRIDE <= WS_WOUT && WS_WOUT + 2 * WOUT_STRIDE <= WS_WUP && WS_WUP + 2 * WUP_STRIDE <= WS_WDN && WS_WDN + 2 * WDN_STRIDE <= WS_KAB, "weights map");
static_assert((size_t)L * DIN * 2 <= 72 * MiB && (size_t)L * NUP * 2 <= 172 * MiB && (size_t)L * DFF * 2 <= 86 * MiB, "scratch map");
constexpr int CW_BAR = 4096;
constexpr int RING_BYTES = 131072, EXTRA_OFF = 131072;
constexpr int TWT_OFF = EXTRA_OFF + 2048;
constexpr int TW12 = 0, TW10 = 2050, TW8 = TW10 + 1024, TW6 = TW8 + 256, TW4 = TW6 + 64, TW2 = TW4 + 16, TW_END = TW2 + 4;
constexpr int LDSCTL_OFF = (TWT_OFF + TW_END * 8 + 63) / 64 * 64, MISC_OFF = LDSCTL_OFF + 320, LDS_BYTES = LDSCTL_OFF + 512;
static_assert(LDS_BYTES <= 163840, "LDS");

#define GAS __attribute__((address_space(1)))
#define LAS __attribute__((address_space(3)))
typedef unsigned short bf16;
typedef unsigned v4u __attribute__((ext_vector_type(4)));
typedef unsigned v2u __attribute__((ext_vector_type(2)));
typedef float f32x4 __attribute__((ext_vector_type(4)));
typedef float f2 __attribute__((ext_vector_type(2)));
typedef GAS unsigned gu32;
#define LDS_WAIT() asm volatile("s_waitcnt lgkmcnt(0)" ::: "memory")
#define VM_WAIT() asm volatile("s_waitcnt vmcnt(0)" ::: "memory")
__device__ __forceinline__ unsigned f2bf(float f) { unsigned u = __builtin_bit_cast(unsigned, f); return (u + 0x7fffu + ((u >> 16) & 1u)) >> 16; }
__device__ __forceinline__ unsigned pk2(float lo, float hi) { return f2bf(lo) | (f2bf(hi) << 16); }
__device__ __forceinline__ float bflo(unsigned w) { return __builtin_bit_cast(float, w << 16); }
__device__ __forceinline__ float bfhi(unsigned w) { return __builtin_bit_cast(float, w & 0xffff0000u); }
__device__ __forceinline__ float bf1(unsigned short h) { return __builtin_bit_cast(float, (unsigned)h << 16); }

#define XB_TMO      128
#define XB_XCNT(j)  (256  + 64 * (j))
#define XB_XSUB(j)  (1280 + 64 * (j))
#define XB_XGEN(j)  (2304 + 64 * (j))
#define XB_TOP      3328
#define XB_TOPGEN   3392
#define XCD_BAR_WORDS 3456
#define XB_SPIN_CAP (1u << 18)
__device__ __forceinline__ unsigned xb_ld(unsigned* p)              { return __hip_atomic_load(p, __ATOMIC_RELAXED, __HIP_MEMORY_SCOPE_AGENT); }
__device__ __forceinline__ unsigned xb_add(unsigned* p, unsigned v) { return __hip_atomic_fetch_add(p, v, __ATOMIC_RELAXED, __HIP_MEMORY_SCOPE_AGENT); }
__device__ __forceinline__ unsigned xb_xcc_id() { return (unsigned)__builtin_amdgcn_s_getreg((3 << 11) | 20) & 0xFu; }
#define XB_SPIN(cond, bar) do { unsigned _sp = 0; while (cond) { __builtin_amdgcn_s_sleep(1); \
    if ((++_sp & 255u) == 0u) { if (xb_ld(&(bar)[XB_TMO])) break; if (_sp > XB_SPIN_CAP) { atomicAdd(&(bar)[XB_TMO], 1u); break; } } } } while (0)
struct XcdBarrier { unsigned* bar; unsigned x; volatile LAS unsigned* st; };
__device__ __forceinline__ XcdBarrier xcd_barrier_post(unsigned* bar, volatile LAS unsigned* st) {
    XcdBarrier b; b.bar = bar; b.x = xb_xcc_id(); b.st = st;
    if (threadIdx.x == 0) (void)xb_add(&bar[XB_XCNT(b.x)], 1u);
    return b;
}
__device__ __forceinline__ void xcd_barrier_complete(unsigned* bar, unsigned x, unsigned& nloc, unsigned& nx) {
    const unsigned G = gridDim.x * gridDim.y * gridDim.z;
    unsigned sum, cnt, mine, sp = 0u;
    for (;;) {
        sum = 0u; cnt = 0u; mine = 0u;
#pragma unroll
        for (unsigned j = 0; j < 16; ++j) { const unsigned c = xb_ld(&bar[XB_XCNT(j)]); sum += c; cnt += (c > 0u) ? 1u : 0u; mine = (j == x) ? c : mine; }
        if (sum == G) break;
        __builtin_amdgcn_s_sleep(1);
        if ((++sp & 255u) == 0u) { if (xb_ld(&bar[XB_TMO])) break; if (sp > XB_SPIN_CAP) { atomicAdd(&bar[XB_TMO], 1u); break; } }
    }
    nloc = mine > 0u ? mine : 1u; nx = cnt > 0u ? cnt : 1u;
}
__device__ __forceinline__ void xcd_barrier(const XcdBarrier& b) {
    asm volatile("s_waitcnt vmcnt(0)" ::: "memory");
    __syncthreads();
    if (threadIdx.x == 0) {
        unsigned* bar = b.bar; asm volatile("" : "+s"(bar));
        __builtin_amdgcn_s_waitcnt(0);
        unsigned nloc = b.st[0], nx = b.st[1];
        if (nloc == 0u) { xcd_barrier_complete(bar, b.x, nloc, nx); b.st[0] = nloc; b.st[1] = nx; }
        const unsigned old = xb_add(&bar[XB_XSUB(b.x)], 1u);
        const unsigned gen = old / nloc;
        if (old + 1u == (gen + 1u) * nloc) {
            __builtin_amdgcn_fence(__ATOMIC_RELEASE, "agent");
            asm volatile("s_waitcnt vmcnt(0)" ::: "memory");
            const unsigned og = xb_add(&bar[XB_TOP], 1u);
            const unsigned tg = og / nx;
            if (og + 1u == (tg + 1u) * nx) xb_add(&bar[XB_TOPGEN], 1u);
            else XB_SPIN(xb_ld(&bar[XB_TOPGEN]) == tg, bar);
            __builtin_amdgcn_fence(__ATOMIC_ACQUIRE, "agent");
            xb_add(&bar[XB_XGEN(b.x)], 1u);
            asm volatile("s_waitcnt vmcnt(0)" ::: "memory");
        } else {
            XB_SPIN(xb_ld(&bar[XB_XGEN(b.x)]) == gen, bar);
            __builtin_amdgcn_fence(__ATOMIC_ACQUIRE, "agent");
            asm volatile("s_waitcnt vmcnt(0)" ::: "memory");
        }
    }
    __syncthreads();
}

struct Frame {
    LAS unsigned char* lds;
    volatile LAS unsigned* MISC;
    int tid, lane, wave, G, bid;
    unsigned char* ws;
};
__device__ __forceinline__ float wave_sum(float v) {
#pragma unroll
    for (int o = 1; o < 64; o <<= 1) v += __shfl_xor(v, o);
    return v;
}
__device__ __forceinline__ float block_sum(float v, LAS float* red, int wave, int lane) {
    v = wave_sum(v);
    __syncthreads();
    if (lane == 0) red[wave] = v;
    __syncthreads();
    float s = 0.f;
#pragma unroll
    for (int w = 0; w < NWAVES; ++w) s += red[w];
    return s;
}

__device__ __forceinline__ void p0_transpose_item(const float* W, int K, int N, bf16* WT, LAS float* scr, int item, int lane) {
    const int nblk = N / 32, kb = item / nblk, nb = item % nblk, k0 = 64 * kb, n0 = 32 * nb;
    float v[32]; const float* src = W + (size_t)(k0 + (lane >> 5)) * N + n0 + (lane & 31);
#pragma unroll
    for (int i = 0; i < 32; ++i) v[i] = src[(size_t)(2 * i) * N];
#pragma unroll
    for (int i = 0; i < 32; ++i) scr[(2 * i + (lane >> 5)) * 33 + (lane & 31)] = v[i];
    LDS_WAIT(); asm volatile("" ::: "memory");
    const int c = lane & 7;
#pragma unroll
    for (int j = 0; j < 4; ++j) { const int n = (lane >> 3) + 8 * j; const LAS float* s = scr + (8 * c) * 33 + n;
        v4u o; o.x = pk2(s[0 * 33], s[1 * 33]); o.y = pk2(s[2 * 33], s[3 * 33]); o.z = pk2(s[4 * 33], s[5 * 33]); o.w = pk2(s[6 * 33], s[7 * 33]);
        *(GAS v4u*)(WT + (size_t)(n0 + n) * K + k0 + 8 * c) = o; }
    LDS_WAIT(); asm volatile("" ::: "memory");
}
__device__ __forceinline__ void ln_row(const float* xin, const float* g, const float* b, float* xout, bf16* xn, int lane) {
    const f32x4* xr = (const f32x4*)xin + lane;
    f32x4 v[8]; float s = 0.f;
#pragma unroll
    for (int j = 0; j < 8; ++j) { v[j] = xr[64 * j]; s += (v[j].x + v[j].y) + (v[j].z + v[j].w); }
    const float mean = wave_sum(s) * (1.f / DM); float s2 = 0.f;
#pragma unroll
    for (int j = 0; j < 8; ++j) { v[j] = v[j] - mean; s2 += (v[j].x * v[j].x + v[j].y * v[j].y) + (v[j].z * v[j].z + v[j].w * v[j].w); }
    const float rstd = 1.f / sqrtf(wave_sum(s2) * (1.f / DM) + LN_EPS);
    f32x4* xo = (f32x4*)xout + lane; v2u* o8 = (v2u*)xn + lane;
#pragma unroll
    for (int j = 0; j < 8; ++j) { const f32x4 gv = ((const f32x4*)g)[64 * j + lane], bv = ((const f32x4*)b)[64 * j + lane];
        const f32x4 o = v[j] * rstd * gv + bv; xo[64 * j] = o; v2u w; w.x = pk2(o.x, o.y); w.y = pk2(o.z, o.w); o8[64 * j] = w; }
}

__device__ __forceinline__ f2 cmul(f2 a, f2 b) { return (f2){a.x * b.x - a.y * b.y, a.x * b.y + a.y * b.x}; }
__device__ __forceinline__ int rev4(int p) { const unsigned x = __brev((unsigned)p) >> 18; return (int)(((x & 0x1555u) << 1) | ((x >> 1) & 0x1555u)); }
__device__ __forceinline__ int fsw(int i) { return i ^ (((i >> 5) & 15) | (((i >> 8) & 1) << 4)); }
__device__ __forceinline__ void fft_tables(LAS unsigned char* lds, const f2* TWg, int tid) {
    LAS f2* T = (LAS f2*)(lds + TWT_OFF);
    for (int i = tid; i <= 2048; i += NTHR) T[TW12 + i] = TWg[i];
    for (int i = tid; i < 1024; i += NTHR) T[TW10 + i] = TWg[i * 4];
    if (tid < 256) T[TW8 + tid] = TWg[tid * 16];
    if (tid < 64) T[TW6 + tid] = TWg[tid * 64];
    if (tid < 16) T[TW4 + tid] = TWg[tid * 256];
    if (tid < 4) T[TW2 + tid] = TWg[tid * 1024];
    __syncthreads();
}
template <int LQ> __device__ __forceinline__ f2 fft_tw(const LAS f2* T, int j) {
    if (LQ == 12) { const bool lo = j <= 2048; const f2 t = T[TW12 + (lo ? j : 4096 - j)]; return lo ? t : (f2){-t.y, -t.x}; }
    constexpr int off = LQ == 10 ? TW10 : LQ == 8 ? TW8 : LQ == 6 ? TW6 : LQ == 4 ? TW4 : TW2;
    return T[off + j];
}
template <int LQ, bool INV> __device__ __forceinline__ void fft_pass(LAS f2* X, const LAS f2* T, int tid) {
    constexpr int q = 1 << LQ, n = 4 * q;
#pragma unroll 4
    for (int i = 0; i < 8; ++i) {
        const int b = tid + NTHR * i, blk = b >> LQ, j = b & (q - 1), base = blk * n + j;
        const int i0 = fsw(base), i1 = fsw(base + q), i2 = fsw(base + 2 * q), i3 = fsw(base + 3 * q);
        f2 a0 = X[i0], a1 = X[i1], a2 = X[i2], a3 = X[i3];
        if (!INV) {
            const f2 t0 = a0 + a2, t1 = a0 - a2, t2 = a1 + a3, d = a1 - a3; const f2 t3 = (f2){d.y, -d.x};
            f2 y0 = t0 + t2, y1 = t1 + t3, y2 = t0 - t2, y3 = t1 - t3;
            if (LQ > 0) { const f2 w1 = fft_tw<LQ>(T, j), w2 = cmul(w1, w1), w3 = cmul(w2, w1); y1 = cmul(y1, w1); y2 = cmul(y2, w2); y3 = cmul(y3, w3); }
            X[i0] = y0; X[i1] = y1; X[i2] = y2; X[i3] = y3;
        } else {
            if (LQ > 0) { f2 w1 = fft_tw<LQ>(T, j); w1.y = -w1.y; const f2 w2 = cmul(w1, w1), w3 = cmul(w2, w1); a1 = cmul(a1, w1); a2 = cmul(a2, w2); a3 = cmul(a3, w3); }
            const f2 t0 = a0 + a2, t1 = a0 - a2, t2 = a1 + a3, d = a1 - a3; const f2 t3 = (f2){-d.y, d.x};
            X[i0] = t0 + t2; X[i1] = t1 + t3; X[i2] = t0 - t2; X[i3] = t1 - t3;
        }
    }
    __syncthreads();
}
__device__ __forceinline__ void r4_dif(f2& a0, f2& a1, f2& a2, f2& a3, const f2 w1, const bool tw) {
    const f2 t0 = a0 + a2, t1 = a0 - a2, t2 = a1 + a3, d = a1 - a3; const f2 t3 = (f2){d.y, -d.x};
    a0 = t0 + t2; a1 = t1 + t3; a2 = t0 - t2; a3 = t1 - t3;
    if (tw) { const f2 w2 = cmul(w1, w1), w3 = cmul(w2, w1); a1 = cmul(a1, w1); a2 = cmul(a2, w2); a3 = cmul(a3, w3); }
}
__device__ __forceinline__ void r4_dit(f2& a0, f2& a1, f2& a2, f2& a3, const f2 w1  , const bool tw) {
    if (tw) { const f2 w2 = cmul(w1, w1), w3 = cmul(w2, w1); a1 = cmul(a1, w1); a2 = cmul(a2, w2); a3 = cmul(a3, w3); }
    const f2 t0 = a0 + a2, t1 = a0 - a2, t2 = a1 + a3, d = a1 - a3; const f2 t3 = (f2){-d.y, d.x};
    a0 = t0 + t2; a1 = t1 + t3; a2 = t0 - t2; a3 = t1 - t3;
}
template <int LQ, bool INV> __device__ __forceinline__ void fft_pair(LAS f2* X, const LAS f2* T, int tid) {
    constexpr int q = 1 << LQ, n16 = 16 * q;
#pragma unroll 1
    for (int i = 0; i < 2; ++i) {
        const int b = tid + NTHR * i, blk = b >> LQ, j = b & (q - 1), base = blk * n16 + j;
        f2 e[16]; int ix[16];
#pragma unroll
        for (int r = 0; r < 16; ++r) { ix[r] = fsw(base + r * q); e[r] = X[ix[r]]; }
        if (!INV) {
#pragma unroll
            for (int c = 0; c < 4; ++c) r4_dif(e[c], e[c + 4], e[c + 8], e[c + 12], fft_tw<LQ + 2>(T, c * q + j), true);
            f2 wB = (f2){1.f, 0.f}; if (LQ > 0) wB = fft_tw<(LQ > 0 ? LQ : 2)>(T, j);
#pragma unroll
            for (int m = 0; m < 4; ++m) r4_dif(e[4 * m], e[4 * m + 1], e[4 * m + 2], e[4 * m + 3], wB, LQ > 0);
        } else {
            f2 wB = (f2){1.f, 0.f}; if (LQ > 0) { wB = fft_tw<(LQ > 0 ? LQ : 2)>(T, j); wB.y = -wB.y; }
#pragma unroll
            for (int m = 0; m < 4; ++m) r4_dit(e[4 * m], e[4 * m + 1], e[4 * m + 2], e[4 * m + 3], wB, LQ > 0);
#pragma unroll
            for (int c = 0; c < 4; ++c) { f2 wA = fft_tw<LQ + 2>(T, c * q + j); wA.y = -wA.y; r4_dit(e[c], e[c + 4], e[c + 8], e[c + 12], wA, true); }
        }
#pragma unroll
        for (int r = 0; r < 16; ++r) X[ix[r]] = e[r];
    }
    __syncthreads();
}
__device__ __forceinline__ void fft_fwd(LAS f2* X, const LAS f2* T, int tid) {
    fft_pass<12, false>(X, T, tid); fft_pair<8, false>(X, T, tid); fft_pair<4, false>(X, T, tid); fft_pair<0, false>(X, T, tid);
}
__device__ __forceinline__ void fft_inv(LAS f2* X, const LAS f2* T, int tid) {
    fft_pair<0, true>(X, T, tid); fft_pair<4, true>(X, T, tid); fft_pair<8, true>(X, T, tid); fft_pass<12, true>(X, T, tid);
}
__device__ __forceinline__ int pw_freq(int wave, int i, int lane) { return ((lane & 31) << 8) | ((wave * 16 + i) << 1) | (lane >> 5); }

struct FiltIn { const float* w3; const float* b3; const float* decay; };
__device__ __forceinline__ void kab_unit(const Frame& F, const FiltIn fi, int l, int pr) {
    LAS f2* X = (LAS f2*)F.lds;
    const LAS f2* T = (const LAS f2*)(F.lds + TWT_OFF);
    LAS float* wsub = (LAS float*)(F.lds + EXTRA_OFF);
    LAS float* red = (LAS float*)(F.lds + EXTRA_OFF + 1024);
    const float* hid = (const float*)(F.ws + WS_HID2) + (size_t)l * L * 64;
    const int c0 = 2 * pr, tid = F.tid;
    if (tid < 256) { const int j = tid >> 2, q = tid & 3; wsub[tid] = fi.w3[((size_t)l * 64 + j) * 2048 + (q >> 1) * 1024 + c0 + (q & 1)]; }
    float b3v[4], dec[4];
#pragma unroll
    for (int q = 0; q < 4; ++q) { b3v[q] = fi.b3[l * 2048 + (q >> 1) * 1024 + c0 + (q & 1)]; dec[q] = fabsf(fi.decay[(l * 2 + (q >> 1)) * 1024 + c0 + (q & 1)]) * (1.0f / (float)(L - 1)); }
    __syncthreads();
    float sa = 0.f, sb = 0.f;
#pragma unroll 1
    for (int i = 0; i < 4; ++i) {
        const int t4 = tid + NTHR * i; const f32x4* col = (const f32x4*)hid + t4;
        f32x4 a0 = (f32x4){b3v[0], b3v[0], b3v[0], b3v[0]}, a1 = (f32x4){b3v[1], b3v[1], b3v[1], b3v[1]}, a2 = (f32x4){b3v[2], b3v[2], b3v[2], b3v[2]}, a3 = (f32x4){b3v[3], b3v[3], b3v[3], b3v[3]};
#pragma unroll 8
        for (int j = 0; j < 64; ++j) { const f32x4 h = col[(size_t)j * (L / 4)]; const f32x4 w = *(const LAS f32x4*)(wsub + j * 4); a0 += h * w.x; a1 += h * w.y; a2 += h * w.z; a3 += h * w.w; }
#pragma unroll
        for (int e = 0; e < 4; ++e) {
            const int t = 4 * t4 + e; const float tf = (float)t;
            const float v0 = a0[e] * __expf(-tf * dec[0]), v1 = a1[e] * __expf(-tf * dec[1]), v2 = a2[e] * __expf(-tf * dec[2]), v3 = a3[e] * __expf(-tf * dec[3]);
            sa += fabsf(v0) + fabsf(v2); sb += fabsf(v1) + fabsf(v3);
            X[fsw(t)] = (f2){v0, v1};
            if (t >= 1) X[fsw(NFFT - t)] = (f2){v2, v3};
        }
    }
    sa = block_sum(sa, red, F.wave, F.lane); sb = block_sum(sb, red, F.wave, F.lane);
    const float ka = 1.0f / (sa * (float)NFFT), kb = 1.0f / (sb * (float)NFFT);
#pragma unroll 2
    for (int i = 0; i < 4; ++i) {
#pragma unroll
        for (int e = 0; e < 4; ++e) { const int t = 4 * (tid + NTHR * i) + e;
            const int p = fsw(t); f2 v = X[p]; v.x *= ka; v.y *= kb; X[p] = v;
            if (t >= 1) { const int p2 = fsw(NFFT - t); f2 w = X[p2]; w.x *= ka; w.y *= kb; X[p2] = w; } }
    }
    if (tid == 0) X[fsw(L)] = (f2){0.f, 0.f};
    __syncthreads();
    fft_fwd(X, T, tid);
    f32x4* KAB = (f32x4*)(F.ws + WS_KAB + (size_t)l * KAB_STRIDE) + (size_t)pr * 8192;
#pragma unroll 2
    for (int i = 0; i < 16; ++i) {
        const int k = pw_freq(F.wave, i, F.lane), idx = (i * 8 + F.wave) * 64 + F.lane;
        f32x4 o;
        if (k == 0) { const f2 k0 = X[fsw(0)], kh = X[fsw(rev4(NFFT / 2))]; o = (f32x4){k0.x, kh.x, k0.y, kh.y}; }
        else { const f2 K1 = X[fsw(rev4(k))], K2 = X[fsw(rev4(NFFT - k))];
            o = (f32x4){0.5f * (K1.x + K2.x), 0.5f * (K1.y - K2.y), 0.5f * (K1.y + K2.y), -0.5f * (K1.x - K2.x)}; }
        KAB[idx] = o;
    }
    __syncthreads();
}

__device__ __forceinline__ void conv_unit(const Frame& F, const float* skip, int l, int pr) {
    LAS f2* X = (LAS f2*)F.lds;
    const LAS f2* T = (const LAS f2*)(F.lds + TWT_OFF);
    const int c0 = 2 * pr, tid = F.tid;
    const float* za = (const float*)(F.ws + WS_ZT) + (size_t)c0 * L; const float* zb = za + L;
#pragma unroll 4
    for (int i = 0; i < 16; ++i) { const int t = tid + NTHR * i; X[fsw(t)] = (f2){za[t], zb[t]}; X[fsw(L + t)] = (f2){0.f, 0.f}; }
    __syncthreads();
    fft_fwd(X, T, tid);
    const f32x4* KAB = (const f32x4*)(F.ws + WS_KAB + (size_t)l * KAB_STRIDE) + (size_t)pr * 8192;
#pragma unroll 2
    for (int i = 0; i < 16; ++i) {
        const int k = pw_freq(F.wave, i, F.lane), idx = (i * 8 + F.wave) * 64 + F.lane;
        const f32x4 kv = KAB[idx];
        if (k == 0) { const int p0 = fsw(0), ph = fsw(rev4(NFFT / 2)); const f2 x0 = X[p0], xh = X[ph]; X[p0] = (f2){x0.x * kv.x, x0.y * kv.z}; X[ph] = (f2){xh.x * kv.y, xh.y * kv.w}; }
        else { const int p = fsw(rev4(k)), pp = fsw(rev4(NFFT - k)); const f2 X1 = X[p], X2 = X[pp];
            const f2 A = (f2){0.5f * (X1.x + X2.x), 0.5f * (X1.y - X2.y)}, B = (f2){0.5f * (X1.y + X2.y), -0.5f * (X1.x - X2.x)};
            const f2 P = cmul(A, (f2){kv.x, kv.y}), Q = cmul(B, (f2){kv.z, kv.w});
            X[p] = (f2){P.x - Q.y, P.y + Q.x}; X[pp] = (f2){P.x + Q.y, Q.x - P.y}; }
    }
    __syncthreads();
    fft_inv(X, T, tid);
    const float ska = skip[l * HWD + c0], skb = skip[l * HWD + c0 + 1];
    float* ya = (float*)(F.ws + WS_YT) + (size_t)c0 * L; float* yb = ya + L;
#pragma unroll 4
    for (int i = 0; i < 16; ++i) { const int t = tid + NTHR * i; const f2 y = X[fsw(t)]; ya[t] = y.x + ska * za[t]; yb[t] = y.y + skb * zb[t]; }
    __syncthreads();
}

struct Args { const float* in[32]; float* out; unsigned char* ws; int ph_lo, ph_hi; };
enum { I_X = 0, I_LNIN_G, I_LNIN_B, I_WIN, I_QG, I_KG, I_HCW, I_HCB, I_FW1, I_FB1, I_FF1, I_FW2, I_FB2, I_FF2, I_FW3, I_FB3, I_DECAY, I_SKIP, I_AOG, I_HOG, I_WOUT, I_BOUT,
       I_LN1G, I_LN1B, I_WUP, I_BUP, I_FCW, I_FCB, I_WDN, I_BDN, I_LN2G, I_LN2B };

__global__ void __launch_bounds__(NTHR, 2) mk_fwd(Args args) {
    extern __shared__ __attribute__((aligned(16))) unsigned char lds[];
    volatile LAS unsigned* const MISCp = (volatile LAS unsigned*)((LAS unsigned char*)lds + MISC_OFF);
    unsigned char* const ws0 = args.ws;
    for (int u = threadIdx.x; u < (LDS_BYTES - LDSCTL_OFF) / 4; u += NTHR) ((LAS unsigned*)((LAS unsigned char*)lds + LDSCTL_OFF))[u] = 0u;
    __syncthreads();
    XcdBarrier bar; bar.bar = (unsigned*)(ws0 + WS_CTL) + CW_BAR; bar.x = 0; bar.st = nullptr;
    if (MK_N_LAUNCHES == 1) bar = xcd_barrier_post((unsigned*)(ws0 + WS_CTL) + CW_BAR, MISCp + 8);
    const int lo = args.ph_lo, hi = args.ph_hi;
    const int wave0 = __builtin_amdgcn_readfirstlane(threadIdx.x >> 6);
#ifdef DBG_ONLY
#define INP(k) ((k) == DBG_ONLY && lo <= (k) && (k) < hi)
#define INL(o) ((o) + 2 == DBG_ONLY && lo <= P + (o) && P + (o) < hi)
#else
#define INP(k) (lo <= (k) && (k) < hi)
#define INL(o) (lo <= P + (o) && P + (o) < hi)
#endif
#define SEAMK(k) do { if (lo <= (k) && (k) + 1 < hi) { for (int rb_ = 0; rb_ < REP_BAR; ++rb_) xcd_barrier(bar); } } while (0)
#define KAS __attribute__((address_space(4)))
#define PF(LV) int tid_, l_ = (LV), bid_ = blockIdx.x; const KAS unsigned char* ka_ = (const KAS unsigned char*)__builtin_amdgcn_kernarg_segment_ptr(); \
    asm volatile("v_mbcnt_lo_u32_b32 %0, -1, 0\n\tv_mbcnt_hi_u32_b32 %0, -1, %0" : "=v"(tid_)); asm volatile("" : "+s"(l_), "+s"(bid_), "+s"(ka_)); tid_ += wave0 * 64; \
    unsigned char* const ws = *(unsigned char* const KAS*)(ka_ + 264); float* const XF = *(float* const KAS*)(ka_ + 256); bf16* const XN = (bf16*)(ws + WS_XN); \
    Frame F; F.lds = (LAS unsigned char*)lds; F.MISC = MISCp; F.tid = tid_; F.lane = tid_ & 63; F.wave = __builtin_amdgcn_readfirstlane(tid_ >> 6); F.G = gridDim.x; F.bid = bid_; F.ws = ws; \
    const int l = l_; const int gw = F.bid * NWAVES + F.wave, NGW = F.G * NWAVES, gtid = F.bid * NTHR + F.tid, NGT = F.G * NTHR; (void)l; (void)gw; (void)NGW; (void)gtid; (void)NGT; (void)XF; (void)XN;
#define AIN(i) (*(const float* const KAS*)(ka_ + 8 * (i)))

    if (INP(0)) { PF(0);
      for (int rep = 0; rep < REP_P0; ++rep) {
        LAS float* scr = (LAS float*)(F.lds + F.wave * 16384);
        constexpr int I_IN = (DM / 64) * (DIN / 32), I_OUT = (DM / 64) * (DM / 32), I_UP = (DM / 64) * (NUP / 32), I_DN = (DFF / 64) * (DM / 32), I_LAYER = I_IN + I_OUT + I_UP + I_DN;
        for (int it = gw; it < DEPTH * I_LAYER; it += NGW) {
            const int l = it / I_LAYER; int r = it % I_LAYER;
            if (r < I_IN) { p0_transpose_item(AIN(I_WIN) + (size_t)l * DM * DIN, DM, DIN, (bf16*)(ws + WS_WIN + l * WIN_STRIDE), scr, r, F.lane); continue; } r -= I_IN;
            if (r < I_OUT) { p0_transpose_item(AIN(I_WOUT) + (size_t)l * DM * DM, DM, DM, (bf16*)(ws + WS_WOUT + l * WOUT_STRIDE), scr, r, F.lane); continue; } r -= I_OUT;
            if (r < I_UP) { p0_transpose_item(AIN(I_WUP) + (size_t)l * DM * NUP, DM, NUP, (bf16*)(ws + WS_WUP + l * WUP_STRIDE), scr, r, F.lane); continue; } r -= I_UP;
            p0_transpose_item(AIN(I_WDN) + (size_t)l * DFF * DM, DFF, DM, (bf16*)(ws + WS_WDN + l * WDN_STRIDE), scr, r, F.lane);
        }
        for (int m = gw; m < L; m += NGW) ln_row(AIN(I_X) + (size_t)m * DM, AIN(I_LNIN_G), AIN(I_LNIN_B), XF + (size_t)m * DM, XN + (size_t)m * DM, F.lane);
        for (int k = gtid; k < NFFT; k += NGT) { float s, c; sincospif((float)k * (2.0f / (float)NFFT), &s, &c); ((f2*)(ws + WS_TWID))[k] = (f2){c, -s}; }
        for (int e = gtid; e < 128 * 32; e += NGT) { const int p = e >> 5, i = e & 31; const float th = exp2f((float)i * (-13.287712379549449f / 32.0f)), ang = (float)p * th; float sn, cs; sincosf(ang, &sn, &cs); ((f2*)(ws + WS_ROPE))[e] = (f2){cs, sn}; }
        for (int it = gw; it < DEPTH * L; it += NGW) {
            const int l = it / L, t = it % L, lane = F.lane;
            const float* w1 = AIN(I_FW1) + l * 33 * 64; const float* w2 = AIN(I_FW2) + l * 64 * 64;
            const float fb = 1e-4f + (float)(lane & 15) * ((15.0f - 1e-4f) / 15.0f);
            float sn, cs; sincospif(fb * ((float)t * (2.0f / (float)L)), &sn, &cs);
            const float cz = cs, sz = -sn;
            float a = AIN(I_FB1)[l * 64 + lane] + ((float)t * (1.0f / (float)(L - 1))) * w1[lane];
#pragma unroll
            for (int i = 0; i < 16; ++i) a += __shfl(cz, i) * w1[(1 + i) * 64 + lane];
#pragma unroll
            for (int i = 0; i < 16; ++i) a += __shfl(sz, i) * w1[(17 + i) * 64 + lane];
            const float h1 = sinf(AIN(I_FF1)[l * 64 + lane] * a);
            float a2 = AIN(I_FB2)[l * 64 + lane];
#pragma unroll 8
            for (int i = 0; i < 64; ++i) a2 += __shfl(h1, i) * w2[i * 64 + lane];
            ((float*)(ws + WS_HID2))[((size_t)l * 64 + lane) * L + t] = sinf(AIN(I_FF2)[l * 64 + lane] * a2);
        }
      }
    }
    SEAMK(0);
    if (INP(1)) { PF(0);
        const FiltIn fi{AIN(I_FW3), AIN(I_FB3), AIN(I_DECAY)};
        fft_tables(F.lds, (const f2*)(ws + WS_TWID), F.tid);
        for (int rep = 0; rep < REP_P0B; ++rep) for (int u = F.bid; u < DEPTH * 512; u += F.G) kab_unit(F, fi, u >> 9, u & 511);
    }
    SEAMK(1);

    for (int lv = 0; lv < DEPTH; ++lv) {
        const int P = 2 + 10 * lv;
        if (INL(0)) { for (int rep = 0; rep < REP_G1; ++rep) { PF(lv); bf16* const PROJ = (bf16*)(ws + WS_PROJ);
            pg8::Gemm g{XN, (const bf16*)(ws + WS_WIN + l * WIN_STRIDE), L, DIN, DM}; pg8::StaticOrder S; S.init(L, DIN, F.G, F.bid);
            pg8::EpiBf16<0> E{PROJ, DIN, nullptr, 0, 0, 1.f};
            pg8::gemm_phase<pg8::EpiBf16<0>, pg8::StaticOrder, PG8_ALIGN, PG8_SP2>(F.lds, g, S, E, F.tid);
        } }
        SEAMK(P + 0);
        if (INL(1)) { PF(lv); bf16* const PROJ = (bf16*)(ws + WS_PROJ); (void)PROJ;
            const f2* ROPE = (const f2*)(ws + WS_ROPE);
            const float* qg = AIN(I_QG) + l * 128; const float* kg = AIN(I_KG) + l * 128;
            for (int it0 = gw; it0 < L * 160 / 64; it0 += 2 * NGW) {
                v4u raw[2]; bf16* pp[2]; int tk[2], subk[2], headk[2];
#pragma unroll
                for (int h = 0; h < 2; ++h) { const int it = it0 + h * NGW; const int g = it * 64 + F.lane; tk[h] = g / 160; const int cc = g % 160; headk[h] = cc >> 4; subk[h] = cc & 15;
                    pp[h] = PROJ + (size_t)tk[h] * DIN + cc * 8; raw[h] = (v4u){0u, 0u, 0u, 0u}; if (it < L * 160 / 64) raw[h] = *(const v4u*)pp[h]; }
#pragma unroll
                for (int h = 0; h < 2; ++h) {
                    const int it = it0 + h * NGW, t = tk[h], sub = subk[h], head = headk[h];
                    float v[8] = {bflo(raw[h].x), bfhi(raw[h].x), bflo(raw[h].y), bfhi(raw[h].y), bflo(raw[h].z), bfhi(raw[h].z), bflo(raw[h].w), bfhi(raw[h].w)};
                    float ss = 0.f;
#pragma unroll
                    for (int e = 0; e < 8; ++e) ss += v[e] * v[e];
                    ss += __shfl_xor(ss, 1); ss += __shfl_xor(ss, 2); ss += __shfl_xor(ss, 4); ss += __shfl_xor(ss, 8);
                    const float rinv = 1.0f / sqrtf(ss * (1.0f / 128.0f) + RMS_EPS);
                    const float* gp = (head < 8 ? qg : kg) + sub * 8;
                    const int pos = (sub < 8) ? (t >> 6) : (t & 63), sub8 = sub & 7;
                    const f2* rp = ROPE + pos * 32 + (sub8 & 3) * 8;
                    float o[8];
#pragma unroll
                    for (int e = 0; e < 8; ++e) v[e] = v[e] * rinv * gp[e];
#pragma unroll
                    for (int e = 0; e < 8; ++e) { const float pv = __shfl_xor(v[e], 4); const f2 cs = rp[e]; o[e] = (sub8 < 4) ? (v[e] * cs.x - pv * cs.y) : (v[e] * cs.x + pv * cs.y); }
                    v4u w; w.x = pk2(o[0], o[1]); w.y = pk2(o[2], o[3]); w.z = pk2(o[4], o[5]); w.w = pk2(o[6], o[7]);
                    if (it < L * 160 / 64) *(v4u*)pp[h] = w;
                }
            }
            LAS float* scr = (LAS float*)(F.lds + F.wave * 16640);
            const float* cw = AIN(I_HCW) + (size_t)l * 3 * 3072; const float* cb = AIN(I_HCB) + (size_t)l * 3072;
            bf16* X0 = (bf16*)(ws + WS_X0); float* ZT = (float*)(ws + WS_ZT);
            for (int rep = 0; rep < REP_P2H; ++rep) for (int it = gw; it < (L / 32) * (HWD / 128); it += NGW) {
                const int tb = it / (HWD / 128), cbk = it % (HWD / 128), t0 = tb * 32, c = cbk * 128 + 2 * F.lane;
                unsigned u[3][34];
#pragma unroll
                for (int gI = 0; gI < 3; ++gI) { const bf16* up = PROJ + C_HY + gI * 1024 + c;
#pragma unroll
                    for (int r = 0; r < 34; ++r) { const int t = t0 - 1 + r; u[gI][r] = (t >= 0 && t < L) ? *(const unsigned*)(up + (size_t)t * DIN) : 0u; } }
                f2 w0[3], w1[3], w2[3], bb[3];
#pragma unroll
                for (int gI = 0; gI < 3; ++gI) { const int col = gI * 1024 + c; w0[gI] = *(const f2*)(cw + col); w1[gI] = *(const f2*)(cw + 3072 + col); w2[gI] = *(const f2*)(cw + 2 * 3072 + col); bb[gI] = *(const f2*)(cb + col); }
#pragma unroll
                for (int tt = 0; tt < 32; ++tt) {
                    f2 r[3];
#pragma unroll
                    for (int gI = 0; gI < 3; ++gI) { const unsigned a = u[gI][tt], m = u[gI][tt + 1], n = u[gI][tt + 2];
                        r[gI] = w0[gI] * (f2){bflo(a), bfhi(a)} + w1[gI] * (f2){bflo(m), bfhi(m)} + w2[gI] * (f2){bflo(n), bfhi(n)} + bb[gI]; }
                    *(unsigned*)(X0 + (size_t)(t0 + tt) * HWD + c) = pk2(r[0].x, r[0].y);
                    scr[tt * 129 + 2 * F.lane] = r[1].x * r[2].x; scr[tt * 129 + 2 * F.lane + 1] = r[1].y * r[2].y;
                }
                LDS_WAIT(); asm volatile("" ::: "memory");
#pragma unroll 8
                for (int i = 0; i < 64; ++i) { const int cl = 2 * i + (F.lane >> 5), tt = F.lane & 31; ZT[(size_t)(cbk * 128 + cl) * L + t0 + tt] = scr[tt * 129 + cl]; }
                LDS_WAIT(); asm volatile("" ::: "memory");
            }
        }
        SEAMK(P + 1);
        if (INL(2)) { PF(lv); bf16* const PROJ = (bf16*)(ws + WS_PROJ); (void)PROJ;
#ifndef DBG_NOATT
            for (int rep = 0; rep < REP_ATT; ++rep) for (int u = F.bid; u < 256; u += F.G) {
                const int x = u & 7, qb = u >> 3, kvh = x >> 2, hq = x;
                const att::bf16* Q = (const att::bf16*)PROJ + (size_t)(qb * 256) * DIN + hq * 128;
                const att::bf16* Kp = (const att::bf16*)PROJ + C_K + kvh * 128;
                const att::bf16* Vp = (const att::bf16*)PROJ + C_V + kvh * 128;
                float* O = (float*)(ws + WS_AO) + (size_t)(qb * 256) * AW + hq * 128;
                att::attn_dense_body<att::bf16>(Q, Kp, Vp, O, L, (char*)lds, F.tid);
                __syncthreads();
            }
#endif
#ifndef DBG_NOCONV
          { PF(lv);
            fft_tables(F.lds, (const f2*)(ws + WS_TWID), F.tid);
            for (int rep = 0; rep < REP_CONV; ++rep) for (int u = F.bid; u < 512; u += F.G) conv_unit(F, AIN(I_SKIP), l, u);
          }
#endif
        }
        SEAMK(P + 2);
        if (INL(3)) { PF(lv); bf16* const PROJ = (bf16*)(ws + WS_PROJ); (void)PROJ;
            LAS float* T = (LAS float*)F.lds;
            const float* YT = (const float*)(ws + WS_YT); const float* AO = (const float*)(ws + WS_AO); const bf16* X0 = (const bf16*)(ws + WS_X0);
            bf16* MIXA = (bf16*)(ws + WS_MIXA);
            const float* ag = AIN(I_AOG) + l * AW; const float* hg = AIN(I_HOG) + l * HWD;
            for (int rep = 0; rep < REP_P4; ++rep) for (int it = F.bid; it < L / 16; it += F.G) {
                const int t0 = it * 16;
#pragma unroll
                for (int h = 0; h < 2; ++h) { const int c = F.tid + NTHR * h; const f32x4* src = (const f32x4*)(YT + (size_t)c * L + t0);
#pragma unroll
                    for (int q = 0; q < 4; ++q) { const f32x4 v = src[q]; T[c * 17 + 4 * q] = v.x; T[c * 17 + 4 * q + 1] = v.y; T[c * 17 + 4 * q + 2] = v.z; T[c * 17 + 4 * q + 3] = v.w; } }
                __syncthreads();
#pragma unroll
                for (int s = 0; s < 2; ++s) {
                    const int tt = 2 * F.wave + s, t = t0 + tt;
                    f32x4 a[4]; float ss = 0.f;
#pragma unroll
                    for (int j = 0; j < 4; ++j) { a[j] = ((const f32x4*)(AO + (size_t)t * AW))[64 * j + F.lane]; ss += (a[j].x * a[j].x + a[j].y * a[j].y) + (a[j].z * a[j].z + a[j].w * a[j].w); }
                    const float ra = 1.0f / sqrtf(wave_sum(ss) * (1.0f / AW) + RMS_EPS);
#pragma unroll
                    for (int j = 0; j < 4; ++j) { const f32x4 gv = ((const f32x4*)ag)[64 * j + F.lane]; const f32x4 o = a[j] * ra * gv;
                        v2u w; w.x = pk2(o.x, o.y); w.y = pk2(o.z, o.w); ((v2u*)(MIXA + (size_t)t * DM))[64 * j + F.lane] = w; }
                    float h0[8], h1[8]; float sh = 0.f;
#pragma unroll
                    for (int k = 0; k < 8; ++k) { const int c = 2 * F.lane + 128 * k; const unsigned xw = *(const unsigned*)(X0 + (size_t)t * HWD + c);
                        h0[k] = bflo(xw) * T[c * 17 + tt]; h1[k] = bfhi(xw) * T[(c + 1) * 17 + tt]; sh += h0[k] * h0[k] + h1[k] * h1[k]; }
                    const float rh = 1.0f / sqrtf(wave_sum(sh) * (1.0f / HWD) + RMS_EPS);
#pragma unroll
                    for (int k = 0; k < 8; ++k) { const int c = 2 * F.lane + 128 * k; const f2 gv = *(const f2*)(hg + c);
                        *(unsigned*)(MIXA + (size_t)t * DM + AW + c) = pk2(h0[k] * rh * gv.x, h1[k] * rh * gv.y); }
                }
                __syncthreads();
            }
        }
        SEAMK(P + 3);
        if (INL(4)) { PF(lv); bf16* const PROJ = (bf16*)(ws + WS_PROJ); (void)PROJ;
            pg8::Gemm g{(const bf16*)(ws + WS_MIXA), (const bf16*)(ws + WS_WOUT + l * WOUT_STRIDE), L, DM, DM}; pg8::StaticOrder S; S.init(L, DM, F.G, F.bid);
            pg8::EpiResid E{XF, DM, AIN(I_BOUT) + l * DM, ALPHA};
            pg8::gemm_phase<pg8::EpiResid, pg8::StaticOrder, PG8_ALIGN, PG8_SP2>(F.lds, g, S, E, F.tid);
        }
        SEAMK(P + 4);
        if (INL(5)) { PF(lv); bf16* const PROJ = (bf16*)(ws + WS_PROJ); (void)PROJ; for (int m = gw; m < L; m += NGW) ln_row(XF + (size_t)m * DM, AIN(I_LN1G) + l * DM, AIN(I_LN1B) + l * DM, XF + (size_t)m * DM, XN + (size_t)m * DM, F.lane); }
        SEAMK(P + 5);
        if (INL(6)) { for (int rep = 0; rep < REP_G7; ++rep) { PF(lv);
            pg8::Gemm g{XN, (const bf16*)(ws + WS_WUP + l * WUP_STRIDE), L, NUP, DM}; pg8::StaticOrder S; S.init(L, NUP, F.G, F.bid);
            pg8::EpiBf16<0> E{(bf16*)(ws + WS_UP), NUP, AIN(I_BUP) + (size_t)l * NUP, 0, 0, 1.f};
            pg8::gemm_phase<pg8::EpiBf16<0>, pg8::StaticOrder, PG8_ALIGN, PG8_SP2>(F.lds, g, S, E, F.tid);
        } }
        SEAMK(P + 6);
        if (INL(7)) { PF(lv); bf16* const PROJ = (bf16*)(ws + WS_PROJ); (void)PROJ;
            const bf16* UP = (const bf16*)(ws + WS_UP); bf16* Gb = (bf16*)(ws + WS_G);
            const float* fw = AIN(I_FCW) + (size_t)l * 3 * DFF; const float* fb = AIN(I_FCB) + (size_t)l * DFF;
            constexpr int NCC = DFF / 8, RB = 8;
            for (int rep = 0; rep < REP_P8; ++rep) for (int it = gtid; it < (L / RB) * NCC; it += NGT) {
                const int cc = it % NCC, tb = it / NCC, j0 = cc * 8, t0 = tb * RB;
                v4u gr[RB + 2], vr[RB];
#pragma unroll
                for (int r = 0; r < RB + 2; ++r) { const int t = t0 - 1 + r; gr[r] = (v4u){0u, 0u, 0u, 0u}; if (t >= 0 && t < L) gr[r] = *(const v4u*)(UP + (size_t)t * NUP + j0); }
#pragma unroll
                for (int r = 0; r < RB; ++r) vr[r] = *(const v4u*)(UP + (size_t)(t0 + r) * NUP + DFF + j0);
                float w0[8], w1[8], w2[8], bb[8];
#pragma unroll
                for (int h = 0; h < 2; ++h) { const f32x4 a = *(const f32x4*)(fw + j0 + 4 * h), b = *(const f32x4*)(fw + DFF + j0 + 4 * h), c = *(const f32x4*)(fw + 2 * DFF + j0 + 4 * h), d = *(const f32x4*)(fb + j0 + 4 * h);
#pragma unroll
                    for (int e = 0; e < 4; ++e) { w0[4 * h + e] = a[e]; w1[4 * h + e] = b[e]; w2[4 * h + e] = c[e]; bb[4 * h + e] = d[e]; } }
#pragma unroll
                for (int tt = 0; tt < RB; ++tt) {
                    const v4u p = gr[tt], c = gr[tt + 1], n = gr[tt + 2], vv = vr[tt];
                    const float pv[8] = {bflo(p.x), bfhi(p.x), bflo(p.y), bfhi(p.y), bflo(p.z), bfhi(p.z), bflo(p.w), bfhi(p.w)};
                    const float cv[8] = {bflo(c.x), bfhi(c.x), bflo(c.y), bfhi(c.y), bflo(c.z), bfhi(c.z), bflo(c.w), bfhi(c.w)};
                    const float nv[8] = {bflo(n.x), bfhi(n.x), bflo(n.y), bfhi(n.y), bflo(n.z), bfhi(n.z), bflo(n.w), bfhi(n.w)};
                    const float vl[8] = {bflo(vv.x), bfhi(vv.x), bflo(vv.y), bfhi(vv.y), bflo(vv.z), bfhi(vv.z), bflo(vv.w), bfhi(vv.w)};
                    float o[8];
#pragma unroll
                    for (int e = 0; e < 8; ++e) { const float x = w0[e] * pv[e] + w1[e] * cv[e] + w2[e] * nv[e] + bb[e];
                        const float u2 = 1.5957691216057308f * (x + 0.044715f * x * x * x);
                        o[e] = x * __builtin_amdgcn_rcpf(1.0f + __expf(-u2)) * vl[e]; }
                    v4u w; w.x = pk2(o[0], o[1]); w.y = pk2(o[2], o[3]); w.z = pk2(o[4], o[5]); w.w = pk2(o[6], o[7]);
                    *(v4u*)(Gb + (size_t)(t0 + tt) * DFF + j0) = w;
                }
            }
        }
        SEAMK(P + 7);
        if (INL(8)) { PF(lv); bf16* const PROJ = (bf16*)(ws + WS_PROJ); (void)PROJ;
            pg8::Gemm g{(const bf16*)(ws + WS_G), (const bf16*)(ws + WS_WDN + l * WDN_STRIDE), L, DM, DFF}; pg8::StaticOrder S; S.init(L, DM, F.G, F.bid);
            pg8::EpiResid E{XF, DM, AIN(I_BDN) + l * DM, ALPHA};
            pg8::gemm_phase<pg8::EpiResid, pg8::StaticOrder, PG8_ALIGN, PG8_SP2>(F.lds, g, S, E, F.tid);
        }
        SEAMK(P + 8);
        if (INL(9)) { PF(lv); bf16* const PROJ = (bf16*)(ws + WS_PROJ); (void)PROJ; for (int m = gw; m < L; m += NGW) ln_row(XF + (size_t)m * DM, AIN(I_LN2G) + l * DM, AIN(I_LN2B) + l * DM, XF + (size_t)m * DM, XN + (size_t)m * DM, F.lane); }
        if (lv + 1 < DEPTH) SEAMK(P + 9);
    }
#undef PF
#undef AIN
#undef INP
#undef INL
#undef SEAMK
}

extern "C" void kernel_launch(void* const* d_in, const int* in_sizes, int n_in, void* d_out, int out_size, void* d_ws, size_t ws_size, hipStream_t stream) {
    static int grid = 0;
    if (grid == 0) {
        if (n_in != 32 || in_sizes[0] != L * DM || out_size != L * DM || ws_size < WS_END) {
            fprintf(stderr, "kernel_launch: built for 32 inputs, x/out of %d floats, >= %zu bytes of workspace; got n_in %d, in0 %d, out %d, ws %zu; nothing launched\n", L * DM, (size_t)WS_END, n_in, n_in > 0 ? in_sizes[0] : -1, out_size, ws_size);
            grid = -1; return; }
        int dev = 0, cus = 0, per_cu = 0;
        if (hipGetDevice(&dev) != hipSuccess || hipDeviceGetAttribute(&cus, hipDeviceAttributeMultiprocessorCount, dev) != hipSuccess) { fprintf(stderr, "kernel_launch: device query failed\n"); grid = -1; return; }
        if (hipFuncSetAttribute((const void*)mk_fwd, hipFuncAttributeMaxDynamicSharedMemorySize, LDS_BYTES) != hipSuccess) { fprintf(stderr, "kernel_launch: hipFuncSetAttribute failed\n"); grid = -1; return; }
        if (hipOccupancyMaxActiveBlocksPerMultiprocessor(&per_cu, (const void*)mk_fwd, NTHR, LDS_BYTES) != hipSuccess || per_cu < 1)
            fprintf(stderr, "kernel_launch: note: occupancy query reports %d workgroups per CU\n", per_cu);
        (void)hipGetLastError();
        grid = cus;
    }
    if (grid < 0) return;
    if (hipMemsetAsync((char*)d_ws + WS_CTL, 0, CTL_ZERO_BYTES, stream) != hipSuccess) { fprintf(stderr, "kernel_launch: hipMemsetAsync failed\n"); return; }
    Args a{};
    for (int i = 0; i < 32; ++i) a.in[i] = (const float*)d_in[i];
    a.out = (float*)d_out; a.ws = (unsigned char*)d_ws;
#if MK_N_LAUNCHES == 1
    a.ph_lo = 0; a.ph_hi = NPHASES;
    hipLaunchKernelGGL(mk_fwd, dim3(grid), dim3(NTHR), LDS_BYTES, stream, a);
#else
    for (int p = 0; p < NPHASES; ++p) { a.ph_lo = p; a.ph_hi = p + 1; hipLaunchKernelGGL(mk_fwd, dim3(grid), dim3(NTHR), LDS_BYTES, stream, a); }
#endif
    const hipError_t le = hipPeekAtLastError();
    if (le != hipSuccess) fprintf(stderr, "kernel_launch: launch failed: %s\n", hipGetErrorName(le));
}
```
